# Optimizing an MI355X kernel written in HIP

```python
import jax, jax.numpy as jnp
from jax import lax
import numpy as np

D_MODEL = 1024
BATCH = 8
SEQ = 2048
DEPTH = 2

D_FF = 2816
CHUNK = 128
A_HEADS = 4
A_HEAD_DIM = 128
D_A = A_HEADS * A_HEAD_DIM
B_GROUPS = 8
B_GROUP_DIM = 64
D_B = B_GROUPS * B_GROUP_DIM
D_MIX = D_A + D_B
D_IN_AB = 2 * D_A + 3 * D_B
CONV_W = 3
POOL_WINDOWS = (2, 4, 8, 16)
POOL_GROUPS = len(POOL_WINDOWS)
POOL_GROUP_DIM = D_MODEL // POOL_GROUPS
N_SUB = 3
N_EVEN = (DEPTH + 1) // 2
N_ODD = DEPTH // 2
EPS = 1e-6

kernel_name = "hybrid_gmlp_shortconv_pool_macaron_adaln"


def rmsnorm(x, g):
    xf = x.astype(jnp.float32)
    y = xf * lax.rsqrt(jnp.mean(xf * xf, axis=-1, keepdims=True) + EPS)
    return (y * g.astype(jnp.float32)).astype(x.dtype)


def layernorm(x, g):
    xf = x.astype(jnp.float32)
    mu = jnp.mean(xf, axis=-1, keepdims=True)
    var = jnp.mean(jnp.square(xf - mu), axis=-1, keepdims=True)
    y = (xf - mu) * lax.rsqrt(var + EPS)
    return (y * g.astype(jnp.float32)).astype(x.dtype)


def modulate(x, g, mod):
    shift, scale, gate = jnp.split(mod, 3, axis=-1)
    h = rmsnorm(x, g) * (1.0 + scale[:, None, :]) + shift[:, None, :]
    return h, gate[:, None, :]


def swiglu(h, w_in, w_out):
    gu = h @ w_in
    g, u = jnp.split(gu, 2, axis=-1)
    return (jax.nn.silu(g) * u) @ w_out


def spatial_gating(u, v, norm_v, w_s, b_s):
    bsz, s, _ = v.shape
    n_chunks = s // CHUNK
    v = layernorm(v, norm_v)
    vc = v.reshape(bsz, n_chunks, CHUNK, A_HEADS, A_HEAD_DIM)
    mask = jnp.tril(jnp.ones((CHUNK, CHUNK), dtype=w_s.dtype))
    z = jnp.einsum('hts,bnshd->bnthd', w_s * mask[None], vc)
    z = z + jnp.transpose(b_s)[None, None, :, :, None]
    return u * z.reshape(bsz, s, D_A)


def causal_short_conv(x, w):
    s = x.shape[1]
    xp = jnp.pad(x, ((0, 0), (CONV_W - 1, 0), (0, 0)))
    y = w[0] * xp[:, 0:s]
    for k in range(1, CONV_W):
        y = y + w[k] * xp[:, k:k + s]
    return y


def mixer_ab(h, w_in, norm_v, w_s, b_s, conv_w, w_out):
    proj = h @ w_in
    u, v, bg, cg, xb = jnp.split(
        proj, [D_A, 2 * D_A, 2 * D_A + D_B, 2 * D_A + 2 * D_B], axis=-1)
    y_a = spatial_gating(jax.nn.gelu(u), jax.nn.gelu(v), norm_v, w_s, b_s)
    y_b = bg * causal_short_conv(cg * xb, conv_w)
    return jnp.concatenate([y_a, y_b], axis=-1) @ w_out


def mixer_pool(h, w_grp, scale):
    s = h.shape[1]
    cum = jnp.cumsum(h.astype(jnp.float32), axis=1)
    t = jnp.arange(s)
    outs = []
    for i, w in enumerate(POOL_WINDOWS):
        sl = slice(i * POOL_GROUP_DIM, (i + 1) * POOL_GROUP_DIM)
        cg = cum[..., sl]
        prev = jnp.pad(cg, ((0, 0), (w, 0), (0, 0)))[:, :s]
        cnt = jnp.minimum(t + 1, w).astype(jnp.float32)[None, :, None]
        p = ((cg - prev) / cnt).astype(h.dtype) - h[..., sl]
        outs.append(p @ w_grp[i])
    return jnp.concatenate(outs, axis=-1) * scale


def setup_inputs(seed: int = 0) -> dict:
    key = jax.random.key(seed)
    ks = jax.random.split(key, 20)
    f32 = jnp.float32
    nrm = lambda k, shape, s: (jax.random.normal(k, shape, f32) * s)
    x = jax.random.normal(ks[0], (BATCH, SEQ, D_MODEL), f32)
    c = jax.random.normal(ks[1], (BATCH, D_MODEL), f32)
    norm_g = 1.0 + nrm(ks[2], (DEPTH, N_SUB, D_MODEL), 0.02)
    w_mod = nrm(ks[3], (DEPTH, D_MODEL, N_SUB * 3 * D_MODEL), 0.5 * D_MODEL ** -0.5)
    b_mod = nrm(ks[4], (DEPTH, N_SUB * 3 * D_MODEL), 0.01)
    w_ffn_in = nrm(ks[5], (DEPTH, 2, D_MODEL, 2 * D_FF), D_MODEL ** -0.5)
    w_ffn_out = nrm(ks[6], (DEPTH, 2, D_FF, D_MODEL), D_FF ** -0.5)
    ab_w_in = nrm(ks[7], (N_EVEN, D_MODEL, D_IN_AB), D_MODEL ** -0.5)
    ab_norm_v = 1.0 + nrm(ks[8], (N_EVEN, D_A), 0.02)
    ab_w_s = nrm(ks[9], (N_EVEN, A_HEADS, CHUNK, CHUNK), CHUNK ** -0.5)
    ab_b_s = 1.0 + nrm(ks[10], (N_EVEN, A_HEADS, CHUNK), 0.02)
    ab_conv_w = nrm(ks[11], (N_EVEN, CONV_W, D_B), CONV_W ** -0.5)
    ab_w_out = nrm(ks[12], (N_EVEN, D_MIX, D_MODEL), D_MIX ** -0.5)
    pool_w_grp = nrm(ks[13], (N_ODD, POOL_GROUPS, POOL_GROUP_DIM, POOL_GROUP_DIM), POOL_GROUP_DIM ** -0.5)
    pool_scale = 1.0 + nrm(ks[14], (N_ODD, D_MODEL), 0.1)
    final_g = 1.0 + nrm(ks[15], (D_MODEL,), 0.02)
    return {"x": x, "c": c, "norm_g": norm_g, "w_mod": w_mod, "b_mod": b_mod,
            "w_ffn_in": w_ffn_in, "w_ffn_out": w_ffn_out,
            "ab_w_in": ab_w_in, "ab_norm_v": ab_norm_v, "ab_w_s": ab_w_s, "ab_b_s": ab_b_s,
            "ab_conv_w": ab_conv_w, "ab_w_out": ab_w_out,
            "pool_w_grp": pool_w_grp, "pool_scale": pool_scale, "final_g": final_g}


def reference(x, c, norm_g, w_mod, b_mod, w_ffn_in, w_ffn_out,
              ab_w_in, ab_norm_v, ab_w_s, ab_b_s, ab_conv_w, ab_w_out,
              pool_w_grp, pool_scale, final_g):
    c_act = jax.nn.silu(c)
    for l in range(DEPTH):
        mod = c_act @ w_mod[l] + b_mod[l]
        mod_f1, mod_mx, mod_f2 = jnp.split(mod, N_SUB, axis=-1)
        h, gate = modulate(x, norm_g[l, 0], mod_f1)
        x = x + 0.5 * gate * swiglu(h, w_ffn_in[l, 0], w_ffn_out[l, 0])
        h, gate = modulate(x, norm_g[l, 1], mod_mx)
        if l % 2 == 0:
            j = l // 2
            y = mixer_ab(h, ab_w_in[j], ab_norm_v[j], ab_w_s[j], ab_b_s[j],
                         ab_conv_w[j], ab_w_out[j])
        else:
            j = l // 2
            y = mixer_pool(h, pool_w_grp[j], pool_scale[j])
        x = x + gate * y
        h, gate = modulate(x, norm_g[l, 2], mod_f2)
        x = x + 0.5 * gate * swiglu(h, w_ffn_in[l, 1], w_ffn_out[l, 1])
    return rmsnorm(x, final_g)
```

```cpp
#include <hip/hip_runtime.h>
#include <hip/hip_cooperative_groups.h>
#include <cstdio>
#include <cstdint>
namespace cg = cooperative_groups;
namespace pg8 {
#define PG8_LAS __attribute__((address_space(3)))
typedef unsigned short bf16_t;
typedef short bf16x8 __attribute__((ext_vector_type(8)));
typedef float f32x4 __attribute__((ext_vector_type(4)));
typedef unsigned u32x4 __attribute__((ext_vector_type(4)));
constexpr int BM = 256, BK = 64, HALF = 128, HTB = HALF * BK * 2  , STAGE_BYTES = 8 * HTB, NXCD = 8, WGM = 8;

__host__ __device__ __forceinline__ int lds_byte(int r, int c) { const int st = (r >> 4) * 2 + (c >> 5), rr = r & 15, cc = c & 31, ob = rr * 64 + cc * 2; return st * 1024 + (ob ^ (((ob >> 9) & 1) << 5)); }
__host__ __device__ __forceinline__ void stage_rc(int b, int& R, int& C) { const int st = b / 1024, sb = b % 1024, swz = sb ^ (((sb >> 9) & 1) << 5); R = (st >> 1) * 16 + swz / 64; C = (st & 1) * 32 + (swz % 64) / 2; }
__host__ __device__ __forceinline__ int perm32(int rho) { const int n = rho >> 4, i = rho & 15; return 8 * (i >> 2) + 4 * n + (i & 3); }

struct Unit { int pm, pn; };
struct Gemm { const bf16_t* A; const bf16_t* Bt; int M, N, K; };

struct StaticOrder {
    int nM, nN, nwg, G, c;
    __host__ __device__ void init(int M, int N, int G_, int c_) { nM = M / BM; nN = N / BM; nwg = nM * nN; G = G_; c = c_; }
    __host__ __device__ bool next(int i, Unit& u) const {
        const long L = (long)i * G + c; if (L >= nwg) return false;
        int wgid = (int)L; { const int q = nwg / NXCD, r = nwg % NXCD, xcd = wgid % NXCD, off = wgid / NXCD; wgid = (xcd < r ? xcd * (q + 1) : r * (q + 1) + (xcd - r) * q) + off; }
        const int nig = WGM * nN, gid = wgid / nig, fm = gid * WGM, gsz = (nM - fm) < WGM ? (nM - fm) : WGM;
        u.pm = fm + ((wgid % nig) % gsz); u.pn = (wgid % nig) / gsz; return true;
    }
    __device__ __forceinline__ void a_ready(const Unit&) const {}
    __device__ __forceinline__ void done(const Unit&) const {}
};

__device__ __forceinline__ unsigned cvt_pk_bf16(float lo, float hi) { unsigned r; asm volatile("v_cvt_pk_bf16_f32 %0, %1, %2" : "=v"(r) : "v"(lo), "v"(hi)); return r; }
template <class Epi, class Sched, bool ALIGN_EPI = false, bool SP2 = false>
__device__ __forceinline__ void gemm_phase(PG8_LAS unsigned char* lds, const Gemm g, const Sched& S, const Epi& E) {
    int tid_l = threadIdx.x; asm volatile("" : "+v"(tid_l));
    const int tid = tid_l, wid = __builtin_amdgcn_readfirstlane(tid >> 6), lane = tid & 63, wr = wid >> 2, wc = wid & 3, fr = lane & 15, fq = lane >> 4;
    const int K = g.K, nt = K / BK;
    unsigned voffA[2], voffB[2];
#pragma unroll
    for (int i = 0; i < 2; ++i) { int R, C; stage_rc(tid * 16 + i * 8192, R, C); const int Rb = Epi::PERM ? ((R & ~31) + perm32(R & 31)) : R;
        voffA[i] = (unsigned)(R * K + C) * 2u; voffB[i] = (unsigned)(Rb * K + C) * 2u; }
    const size_t kstep = (size_t)(BK * 2);
    const size_t hstep = (size_t)HALF * K * 2;
    const size_t tstep = 2 * hstep;
    const unsigned ldsw = (unsigned)wid * 1024u;
    const int aoff = lds_byte(wr * 64 + fr, fq * 8), boff = lds_byte(wc * 32 + fr, fq * 8);
#define PG8_SA(b, h) (((b) * 2 + (h)) * HTB)
#define PG8_SB(b, h) ((4 + (b) * 2 + (h)) * HTB)
#define PG8_STAGE(bufoff, gbase, voff) do { _Pragma("unroll") for (int _i = 0; _i < 2; ++_i) \
        __builtin_amdgcn_global_load_lds((const unsigned*)((const char*)(gbase) + (voff)[_i]), (PG8_LAS unsigned*)(lds + (bufoff) + ldsw + _i * 8192), 16, 0, 0); } while (0)
#define PG8_LDA(dst, b, h) do { _Pragma("unroll") for (int m = 0; m < 4; ++m) _Pragma("unroll") for (int k = 0; k < 2; ++k) dst[m][k] = *(const PG8_LAS bf16x8*)(lds + PG8_SA(b, h) + aoff + m * 2048 + k * 1024); } while (0)
#define PG8_LDB(dst, b, h) do { _Pragma("unroll") for (int n = 0; n < 2; ++n) _Pragma("unroll") for (int k = 0; k < 2; ++k) dst[n][k] = *(const PG8_LAS bf16x8*)(lds + PG8_SB(b, h) + boff + n * 2048 + k * 1024); } while (0)
#define PG8_MMA(ai, bj, At, Bt) do { __builtin_amdgcn_s_setprio(1); _Pragma("unroll") for (int m = 0; m < 4; ++m) _Pragma("unroll") for (int n = 0; n < 2; ++n) _Pragma("unroll") for (int k = 0; k < 2; ++k) \
        acc[ai][bj][m][n] = __builtin_amdgcn_mfma_f32_16x16x32_bf16(Bt[n][k], At[m][k], acc[ai][bj][m][n], 0, 0, 0); __builtin_amdgcn_s_setprio(0); } while (0)
#define PG8_WAIT_V(n) asm volatile("s_waitcnt vmcnt(" #n ")" ::: "memory")
#define PG8_WAIT_L(n) asm volatile("s_waitcnt lgkmcnt(" #n ")" ::: "memory")
#define PG8_BAR __builtin_amdgcn_s_barrier()
#define PG8_SCHED __builtin_amdgcn_sched_barrier(0)
    Unit cur, nxt; int ui = 0;
    if (!S.next(0, cur)) return;
    f32x4 acc[2][2][4][2];
#pragma unroll
    for (int a = 0; a < 2; ++a)
#pragma unroll
        for (int b = 0; b < 2; ++b)
#pragma unroll
            for (int m = 0; m < 4; ++m)
#pragma unroll
                for (int n = 0; n < 2; ++n) acc[a][b][m][n] = (f32x4){0.f, 0.f, 0.f, 0.f};
    bf16x8 At[4][2], B0[2][2], B1[2][2];
    const char* cA = (const char*)g.A + (size_t)cur.pm * tstep; const char* cB = (const char*)g.Bt + (size_t)cur.pn * tstep;
    S.a_ready(cur);
    if constexpr (SP2) {
        PG8_STAGE(PG8_SB(0, 0), cB, voffB); PG8_STAGE(PG8_SB(0, 1), cB + hstep, voffB); PG8_STAGE(PG8_SA(0, 0), cA, voffA); PG8_STAGE(PG8_SA(0, 1), cA + hstep, voffA);
        if (wr == 1) PG8_BAR;
        PG8_WAIT_V(2); PG8_BAR;
        PG8_STAGE(PG8_SB(1, 0), cB + kstep, voffB); PG8_STAGE(PG8_SA(1, 0), cA + kstep, voffA); PG8_STAGE(PG8_SB(1, 1), cB + hstep + kstep, voffB);
        PG8_WAIT_V(6); PG8_BAR;
    } else {
        PG8_STAGE(PG8_SB(0, 0), cB, voffB); PG8_STAGE(PG8_SA(0, 0), cA, voffA); PG8_STAGE(PG8_SB(0, 1), cB + hstep, voffB); PG8_STAGE(PG8_SA(0, 1), cA + hstep, voffA);
        if (wr == 1) PG8_BAR;
        PG8_WAIT_V(4); PG8_BAR;
        PG8_STAGE(PG8_SB(1, 0), cB + kstep, voffB); PG8_STAGE(PG8_SA(1, 0), cA + kstep, voffA); PG8_STAGE(PG8_SB(1, 1), cB + hstep + kstep, voffB);
        PG8_WAIT_V(6); PG8_BAR;
    }
    for (;;) {
        const bool has_next = S.next(ui + 1, nxt);
        const char* nA = has_next ? (const char*)g.A + (size_t)nxt.pm * tstep : cA; const char* nB = has_next ? (const char*)g.Bt + (size_t)nxt.pn * tstep : cB;
        for (int t = 0; t < nt; t += 2) {
            const bool last = (t == nt - 2);
            const char* a1 = cA + (size_t)(t + 1) * kstep;
            const char* a2 = last ? nA : cA + (size_t)(t + 2) * kstep; const char* b2 = last ? nB : cB + (size_t)(t + 2) * kstep;
            const char* a3 = a2 + kstep; const char* b3 = b2 + kstep;
            if (last && has_next) S.a_ready(nxt);
            if constexpr (SP2) {
            PG8_LDB(B0, 0, 0); PG8_LDB(B1, 0, 1); PG8_SCHED; PG8_LDA(At, 0, 0); PG8_STAGE(PG8_SA(1, 1), a1 + hstep, voffA);
            PG8_WAIT_V(8); PG8_WAIT_L(0); PG8_BAR; PG8_MMA(0, 0, At, B0); PG8_MMA(0, 1, At, B1); PG8_BAR; PG8_SCHED;
            PG8_LDA(At, 0, 1); PG8_STAGE(PG8_SB(0, 0), b2, voffB); PG8_STAGE(PG8_SB(0, 1), b2 + hstep, voffB); PG8_STAGE(PG8_SA(0, 0), a2, voffA);
            PG8_WAIT_V(8); PG8_WAIT_L(0); PG8_BAR; PG8_MMA(1, 0, At, B0); PG8_MMA(1, 1, At, B1); PG8_BAR; PG8_SCHED;
            PG8_LDB(B0, 1, 0); PG8_LDB(B1, 1, 1); PG8_SCHED; PG8_LDA(At, 1, 0); PG8_STAGE(PG8_SA(0, 1), a2 + hstep, voffA);
            PG8_WAIT_V(8); PG8_WAIT_L(0); PG8_BAR; PG8_MMA(0, 0, At, B0); PG8_MMA(0, 1, At, B1); PG8_BAR; PG8_SCHED;
            PG8_LDA(At, 1, 1); PG8_STAGE(PG8_SB(1, 0), b3, voffB); PG8_STAGE(PG8_SB(1, 1), b3 + hstep, voffB); PG8_STAGE(PG8_SA(1, 0), a3, voffA);
            PG8_WAIT_V(8); PG8_WAIT_L(0); PG8_BAR; PG8_MMA(1, 0, At, B0); PG8_MMA(1, 1, At, B1); PG8_BAR; PG8_SCHED;
            } else {
            PG8_LDB(B0, 0, 0); PG8_SCHED; PG8_LDA(At, 0, 0); PG8_STAGE(PG8_SA(1, 1), a1 + hstep, voffA);
            PG8_WAIT_L(8); PG8_BAR; PG8_WAIT_L(0); PG8_MMA(0, 0, At, B0); PG8_BAR; PG8_SCHED;
            PG8_LDB(B1, 0, 1); PG8_STAGE(PG8_SB(0, 0), b2, voffB);
            PG8_BAR; PG8_WAIT_L(0); PG8_MMA(0, 1, At, B1); PG8_BAR;
            PG8_LDA(At, 0, 1); PG8_STAGE(PG8_SA(0, 0), a2, voffA);
            PG8_BAR; PG8_WAIT_L(0); PG8_MMA(1, 0, At, B0); PG8_BAR; PG8_SCHED;
            PG8_STAGE(PG8_SB(0, 1), b2 + hstep, voffB);
            PG8_WAIT_V(6); PG8_BAR; PG8_MMA(1, 1, At, B1); PG8_BAR;
            PG8_LDB(B0, 1, 0); PG8_SCHED; PG8_LDA(At, 1, 0); PG8_STAGE(PG8_SA(0, 1), a2 + hstep, voffA);
            PG8_WAIT_L(8); PG8_BAR; PG8_WAIT_L(0); PG8_MMA(0, 0, At, B0); PG8_BAR; PG8_SCHED;
            PG8_LDB(B1, 1, 1); PG8_STAGE(PG8_SB(1, 0), b3, voffB);
            PG8_BAR; PG8_WAIT_L(0); PG8_MMA(0, 1, At, B1); PG8_BAR;
            PG8_LDA(At, 1, 1); PG8_STAGE(PG8_SA(1, 0), a3, voffA);
            PG8_BAR; PG8_WAIT_L(0); PG8_MMA(1, 0, At, B0); PG8_BAR; PG8_SCHED;
            PG8_STAGE(PG8_SB(1, 1), b3 + hstep, voffB);
            PG8_WAIT_V(6); PG8_BAR; PG8_MMA(1, 1, At, B1); PG8_BAR;
            }
        }
        if constexpr (ALIGN_EPI) { if (wr == 0) PG8_BAR; }
        if constexpr (!Epi::AFTER_DRAIN) { E(acc, cur, wr, wc, fr, fq); S.done(cur); }
        if (!has_next) break;
#pragma unroll
        for (int a = 0; a < 2; ++a)
#pragma unroll
            for (int b = 0; b < 2; ++b)
#pragma unroll
                for (int m = 0; m < 4; ++m)
#pragma unroll
                    for (int n = 0; n < 2; ++n) acc[a][b][m][n] = (f32x4){0.f, 0.f, 0.f, 0.f};
        cur = nxt; cA = nA; cB = nB; ++ui;
        if constexpr (ALIGN_EPI) { if (wr == 1) PG8_BAR; }
    }
    PG8_WAIT_V(0);
    if constexpr (!ALIGN_EPI) { if (wr == 0) PG8_BAR; }
    PG8_BAR;
    if constexpr (Epi::AFTER_DRAIN) { E.fused(acc, cur, wr, wc, fr, fq, lds, wid, lane); S.done(cur); }
#undef PG8_SA
#undef PG8_SB
#undef PG8_STAGE
#undef PG8_LDA
#undef PG8_LDB
#undef PG8_MMA
#undef PG8_WAIT_V
#undef PG8_WAIT_L
#undef PG8_BAR
#undef PG8_SCHED
}
}
#define GAS __attribute__((address_space(1)))
#define LAS __attribute__((address_space(3)))
typedef unsigned short bf16;
typedef unsigned v4u __attribute__((ext_vector_type(4)));
typedef unsigned v2u __attribute__((ext_vector_type(2)));
typedef float f32x4 __attribute__((ext_vector_type(4)));
typedef short bf16x8 __attribute__((ext_vector_type(8)));
#define LDS_WAIT() asm volatile("s_waitcnt lgkmcnt(0)" ::: "memory")
__device__ __forceinline__ unsigned f2bf(float f) { unsigned u = __builtin_bit_cast(unsigned, f); return (u + 0x7fffu + ((u >> 16) & 1u)) >> 16; }
__device__ __forceinline__ unsigned pk2(float lo, float hi) { return f2bf(lo) | (f2bf(hi) << 16); }
#define XB_TMO      128
#define XB_XCNT(j)  (256  + 64 * (j))
#define XB_XSUB(j)  (1280 + 64 * (j))
#define XB_XGEN(j)  (2304 + 64 * (j))
#define XB_TOP      3328
#define XB_TOPGEN   3392
#define XCD_BAR_WORDS 3456
#define XB_SPIN_CAP (1u << 18)

__device__ __forceinline__ unsigned xb_ld(unsigned* p)              { return __hip_atomic_load(p, __ATOMIC_RELAXED, __HIP_MEMORY_SCOPE_AGENT); }
__device__ __forceinline__ unsigned xb_add(unsigned* p, unsigned v) { return __hip_atomic_fetch_add(p, v, __ATOMIC_RELAXED, __HIP_MEMORY_SCOPE_AGENT); }
__device__ __forceinline__ unsigned xb_xcc_id() { return (unsigned)__builtin_amdgcn_s_getreg((3 << 11) | 20) & 0xFu; }
#define XB_SPIN(cond, bar) do { unsigned _sp = 0; while (cond) { __builtin_amdgcn_s_sleep(1); \
    if ((++_sp & 255u) == 0u) { if (xb_ld(&(bar)[XB_TMO])) break; if (_sp > XB_SPIN_CAP) { atomicAdd(&(bar)[XB_TMO], 1u); break; } } } } while (0)

struct XcdBarrier {
    unsigned* bar; unsigned x;
    volatile LAS unsigned* st;
};

__device__ __forceinline__ XcdBarrier xcd_barrier_post(unsigned* bar, volatile LAS unsigned* st) {
    XcdBarrier b; b.bar = bar; b.x = xb_xcc_id(); b.st = st;
    if (threadIdx.x == 0) (void)xb_add(&bar[XB_XCNT(b.x)], 1u);
    return b;
}
__device__ __forceinline__ void xcd_barrier_complete(unsigned* bar, unsigned x, unsigned& nloc, unsigned& nx) {
    const unsigned G = gridDim.x * gridDim.y * gridDim.z;
    unsigned sum, cnt, mine, sp = 0u;
    for (;;) {
        sum = 0u; cnt = 0u; mine = 0u;
#pragma unroll
        for (unsigned j = 0; j < 16; ++j) { const unsigned c = xb_ld(&bar[XB_XCNT(j)]); sum += c; cnt += (c > 0u) ? 1u : 0u; mine = (j == x) ? c : mine; }
        if (sum == G) break;
        __builtin_amdgcn_s_sleep(1);
        if ((++sp & 255u) == 0u) { if (xb_ld(&bar[XB_TMO])) break; if (sp > XB_SPIN_CAP) { atomicAdd(&bar[XB_TMO], 1u); break; } }
    }
    nloc = mine > 0u ? mine : 1u; nx = cnt > 0u ? cnt : 1u;
}

__device__ __forceinline__ void xcd_barrier(const XcdBarrier& b) {
    asm volatile("s_waitcnt vmcnt(0)" ::: "memory");
    __syncthreads();
    if (threadIdx.x == 0) {
        unsigned* bar = b.bar;
        __builtin_amdgcn_s_waitcnt(0);
        unsigned nloc = b.st[0], nx = b.st[1];
        if (nloc == 0u) { xcd_barrier_complete(bar, b.x, nloc, nx); b.st[0] = nloc; b.st[1] = nx; }
        const unsigned old = xb_add(&bar[XB_XSUB(b.x)], 1u);
        const unsigned gen = old / nloc;
        if (old + 1u == (gen + 1u) * nloc) {
            __builtin_amdgcn_fence(__ATOMIC_RELEASE, "agent");
            asm volatile("s_waitcnt vmcnt(0)" ::: "memory");
            const unsigned og = xb_add(&bar[XB_TOP], 1u);
            const unsigned tg = og / nx;
            if (og + 1u == (tg + 1u) * nx) xb_add(&bar[XB_TOPGEN], 1u);
            else XB_SPIN(xb_ld(&bar[XB_TOPGEN]) == tg, bar);
            __builtin_amdgcn_fence(__ATOMIC_ACQUIRE, "agent");
            xb_add(&bar[XB_XGEN(b.x)], 1u);
            asm volatile("s_waitcnt vmcnt(0)" ::: "memory");
        } else {
            XB_SPIN(xb_ld(&bar[XB_XGEN(b.x)]) == gen, bar);
            __builtin_amdgcn_fence(__ATOMIC_ACQUIRE, "agent");
            asm volatile("s_waitcnt vmcnt(0)" ::: "memory");
        }
    }
    __syncthreads();
}


constexpr int T = 16384, D = 1024, FF = 2816, NIN = 5632, NAB = 2560, MODW = 9216;
constexpr float EPS = 1e-6f;
constexpr size_t MiB = 1u << 20;
constexpr size_t WS_CTL = 0, CTL_ZERO_BYTES = 64 * 1024;
constexpr int CW_BAR = 1024;
constexpr size_t WS_MOD = 1 * MiB;
constexpr size_t WS_GK = 2 * MiB;
constexpr size_t WS_GATE = 2 * MiB + 256 * 1024;
constexpr size_t WS_BIAS = 3 * MiB;
constexpr size_t BIAS_STRIDE_F = 65536;
constexpr size_t WS_ROWSS = 5 * MiB;
constexpr size_t WS_WS = 6 * MiB;
constexpr size_t WS_WGT = 6 * MiB + 512 * 1024;
constexpr size_t WS_WIN = 8 * MiB;
constexpr size_t WS_WOUT = 52 * MiB;
constexpr size_t WS_ABIN = 74 * MiB;
constexpr size_t WS_ABOUT = 79 * MiB;
constexpr size_t WS_XB = 82 * MiB;
constexpr size_t WS_YMIX = 114 * MiB;
constexpr size_t WS_ACT = 146 * MiB;
constexpr size_t WS_X2 = 236 * MiB;
constexpr size_t WS_END = 300 * MiB;

constexpr int RING_BYTES = 131072, LDSCTL_OFF = RING_BYTES, MISC_OFF = LDSCTL_OFF + 320, LDS_BYTES = 147456;

__device__ __forceinline__ float wave_sum(float v) {
#pragma unroll
    for (int o = 1; o < 64; o <<= 1) v += __shfl_xor(v, o);
    return v;
}
__device__ __forceinline__ float bflo(unsigned u) { return __uint_as_float(u << 16); }
__device__ __forceinline__ float bfhi(unsigned u) { return __uint_as_float(u & 0xffff0000u); }
__device__ __forceinline__ float silu_f(float x) { return x * __builtin_amdgcn_rcpf(1.f + __builtin_amdgcn_exp2f(-1.44269504f * x)); }
__device__ __forceinline__ float gelu_tanh_f(float x) { const float u = 0.7978845608f * (x + 0.044715f * x * x * x); return x * __builtin_amdgcn_rcpf(1.f + __builtin_amdgcn_exp2f(-2.88539008f * u)); }
__device__ __forceinline__ f32x4 mfma16(bf16x8 a, bf16x8 b, f32x4 c) { return __builtin_amdgcn_mfma_f32_16x16x32_bf16(a, b, c, 0, 0, 0); }

struct EpiSwiglu {
    static constexpr bool PERM = true, AFTER_DRAIN = false;
    bf16* O; const float* rowss; const float* bias;
    __device__ __forceinline__ void operator()(const f32x4 (&acc)[2][2][4][2], const pg8::Unit& u, int wr, int wc, int fr, int fq) const {
        const int b = u.pm >> 3;
        const float* bp = bias + b * NIN + u.pn * 256 + wc * 32 + 8 * fq;
        f32x4 bg[2], bu[2];
#pragma unroll
        for (int n = 0; n < 2; ++n) { bg[n] = *(const f32x4*)(bp + 4 * n); bu[n] = *(const f32x4*)(bp + 128 + 4 * n); }
        const int hid0 = u.pn * 128 + wc * 32 + 8 * fq;
#pragma unroll
        for (int ai = 0; ai < 2; ++ai)
#pragma unroll
            for (int m = 0; m < 4; ++m) {
                const int row = u.pm * 256 + ai * 128 + wr * 64 + m * 16 + fr;
                const float rs = rsqrtf(rowss[row] * (1.f / 1024.f) + EPS);
                v4u w;
#pragma unroll
                for (int n = 0; n < 2; ++n) {
                    const f32x4 g = acc[ai][0][m][n] * rs + bg[n], uu = acc[ai][1][m][n] * rs + bu[n];
                    const float a0 = silu_f(g[0]) * uu[0], a1 = silu_f(g[1]) * uu[1], a2 = silu_f(g[2]) * uu[2], a3 = silu_f(g[3]) * uu[3];
                    if (n == 0) { w.x = pg8::cvt_pk_bf16(a0, a1); w.y = pg8::cvt_pk_bf16(a2, a3); } else { w.z = pg8::cvt_pk_bf16(a0, a1); w.w = pg8::cvt_pk_bf16(a2, a3); }
                }
                *(v4u*)(O + (size_t)row * FF + hid0) = w;
            }
    }
};
struct EpiProj {
    static constexpr bool PERM = true, AFTER_DRAIN = false;
    bf16* O; const float* rowss; const float* bias;
    __device__ __forceinline__ void operator()(const f32x4 (&acc)[2][2][4][2], const pg8::Unit& u, int wr, int wc, int fr, int fq) const {
        const int b = u.pm >> 3; const int col0 = u.pn * 256 + wc * 32 + 8 * fq;
        const float* bp = bias + b * NAB + col0;
        f32x4 bv[2][2];
#pragma unroll
        for (int bj = 0; bj < 2; ++bj)
#pragma unroll
            for (int n = 0; n < 2; ++n) bv[bj][n] = *(const f32x4*)(bp + 128 * bj + 4 * n);
        const bool act = u.pn < 4;
#pragma unroll
        for (int ai = 0; ai < 2; ++ai)
#pragma unroll
            for (int m = 0; m < 4; ++m) {
                const int row = u.pm * 256 + ai * 128 + wr * 64 + m * 16 + fr;
                const float rs = rsqrtf(rowss[row] * (1.f / 1024.f) + EPS);
#pragma unroll
                for (int bj = 0; bj < 2; ++bj) {
                    f32x4 v0 = acc[ai][bj][m][0] * rs + bv[bj][0], v1 = acc[ai][bj][m][1] * rs + bv[bj][1];
                    if (act) {
#pragma unroll
                        for (int j = 0; j < 4; ++j) { v0[j] = gelu_tanh_f(v0[j]); v1[j] = gelu_tanh_f(v1[j]); } }
                    v4u w; w.x = pg8::cvt_pk_bf16(v0[0], v0[1]); w.y = pg8::cvt_pk_bf16(v0[2], v0[3]); w.z = pg8::cvt_pk_bf16(v1[0], v1[1]); w.w = pg8::cvt_pk_bf16(v1[2], v1[3]);
                    *(v4u*)(O + (size_t)row * NAB + col0 + 128 * bj) = w;
                }
            }
    }
};
struct EpiResid {
    static constexpr bool PERM = true, AFTER_DRAIN = false;
    const float* xin; float* xout; const float* gate; float* rowss_next; const float* gk_next; bf16* xb;
    __device__ __forceinline__ void operator()(const f32x4 (&acc)[2][2][4][2], const pg8::Unit& u, int wr, int wc, int fr, int fq) const {
        const int b = u.pm >> 3; const int col0 = u.pn * 256 + wc * 32 + 8 * fq;
        f32x4 gt[2][2], gk[2][2];
#pragma unroll
        for (int bj = 0; bj < 2; ++bj)
#pragma unroll
            for (int n = 0; n < 2; ++n) {
                gt[bj][n] = *(const f32x4*)(gate + b * 1024 + col0 + 128 * bj + 4 * n);
                gk[bj][n] = gk_next ? *(const f32x4*)(gk_next + b * 1024 + col0 + 128 * bj + 4 * n) : (f32x4){0.f, 0.f, 0.f, 0.f};
            }
#pragma unroll
        for (int ai = 0; ai < 2; ++ai)
#pragma unroll
            for (int m = 0; m < 4; ++m) {
                const int row = u.pm * 256 + ai * 128 + wr * 64 + m * 16 + fr;
                float ss = 0.f;
#pragma unroll
                for (int bj = 0; bj < 2; ++bj) {
                    const size_t off = (size_t)row * D + col0 + 128 * bj;
                    f32x4 x0 = *(const f32x4*)(xin + off), x1 = *(const f32x4*)(xin + off + 4);
                    x0 += gt[bj][0] * acc[ai][bj][m][0]; x1 += gt[bj][1] * acc[ai][bj][m][1];
                    *(f32x4*)(xout + off) = x0; *(f32x4*)(xout + off + 4) = x1;
                    ss += (x0[0] * x0[0] + x0[1] * x0[1]) + (x0[2] * x0[2] + x0[3] * x0[3]) + (x1[0] * x1[0] + x1[1] * x1[1]) + (x1[2] * x1[2] + x1[3] * x1[3]);
                    if (gk_next) { const f32x4 y0 = x0 * gk[bj][0], y1 = x1 * gk[bj][1];
                        v4u w; w.x = pg8::cvt_pk_bf16(y0[0], y0[1]); w.y = pg8::cvt_pk_bf16(y0[2], y0[3]); w.z = pg8::cvt_pk_bf16(y1[0], y1[1]); w.w = pg8::cvt_pk_bf16(y1[2], y1[3]);
                        *(v4u*)(xb + off) = w; }
                }
                ss += __shfl_xor(ss, 16); ss += __shfl_xor(ss, 32);
                if (fq == 0) unsafeAtomicAdd(rowss_next + row, ss);
                asm volatile("" ::: "memory");
            }
    }
};

__device__ __forceinline__ void transpose_item(const float* W, int K, int N, bf16* WT, int mode, LAS float* scr, int item, int lane) {
    const int nblk = N / 32, kb = item / nblk, nb = item % nblk, k0 = 64 * kb, n0 = 32 * nb;
    int drow0 = n0;
    if (mode == 1) { const int j = n0 < FF ? n0 : n0 - FF; drow0 = (j >> 7) * 256 + (j & 127) + (n0 < FF ? 0 : 128); }
#pragma unroll 8
    for (int i = 0; i < 32; ++i) { const int kk = 2 * i + (lane >> 5); scr[kk * 33 + (lane & 31)] = W[(size_t)(k0 + kk) * N + n0 + (lane & 31)]; }
    LDS_WAIT(); asm volatile("" ::: "memory");
    const int c = lane & 7;
#pragma unroll
    for (int j = 0; j < 4; ++j) { const int n = (lane >> 3) + 8 * j; const LAS float* s = scr + (8 * c) * 33 + n;
        v4u o; o.x = pk2(s[0 * 33], s[1 * 33]); o.y = pk2(s[2 * 33], s[3 * 33]); o.z = pk2(s[4 * 33], s[5 * 33]); o.w = pk2(s[6 * 33], s[7 * 33]);
        *(v4u*)(WT + (size_t)(drow0 + n) * K + k0 + 8 * c) = o; }
    LDS_WAIT(); asm volatile("" ::: "memory");
}
__device__ __forceinline__ void mod_task(const float* c, const float* w_mod, const float* b_mod, float* MOD, LAS float* fl, int task, int tid, int wave, int lane) {
    const int l = task / 72, cgp = task % 72;
    for (int i = tid; i < 8192; i += 512) { const float v = c[i]; fl[i] = v / (1.f + __expf(-v)); }
    __syncthreads();
    const int col = cgp * 128 + lane * 2;
    const float* wp = w_mod + (size_t)l * D * MODW + (size_t)(wave * 128) * MODW + col;
    float acc[8][2];
#pragma unroll
    for (int b = 0; b < 8; ++b) { acc[b][0] = 0.f; acc[b][1] = 0.f; }
#pragma unroll 16
    for (int k = 0; k < 128; ++k) {
        const float2 w = *(const float2*)(wp + (size_t)k * MODW);
#pragma unroll
        for (int b = 0; b < 8; ++b) { const float cv = fl[b * 1024 + wave * 128 + k]; acc[b][0] += cv * w.x; acc[b][1] += cv * w.y; }
    }
#pragma unroll
    for (int b = 0; b < 8; ++b) { fl[8192 + (wave * 8 + b) * 128 + lane * 2] = acc[b][0]; fl[8192 + (wave * 8 + b) * 128 + lane * 2 + 1] = acc[b][1]; }
    __syncthreads();
    for (int o = tid; o < 1024; o += 512) { const int b = o >> 7, cc = o & 127; float s = 0.f;
#pragma unroll
        for (int w = 0; w < 8; ++w) s += fl[8192 + (w * 8 + b) * 128 + cc];
        MOD[(size_t)(l * 8 + b) * MODW + cgp * 128 + cc] = s + b_mod[l * MODW + cgp * 128 + cc]; }
    __syncthreads();
}
__device__ __forceinline__ bf16x8 pack8(const float (&v)[8]) {
    v4u o; o.x = pk2(v[0], v[1]); o.y = pk2(v[2], v[3]); o.z = pk2(v[4], v[5]); o.w = pk2(v[6], v[7]);
    return __builtin_bit_cast(bf16x8, o);
}

__device__ __forceinline__ void mid_phase(const bf16* PROJ, bf16* YMIX, const bf16* WST, const float* norm_v, const float* b_s, const float* conv_w,
                                          LAS unsigned char* lds, int bx, int G, int wave, int lane) {
    LAS bf16* vT = (LAS bf16*)lds; constexpr int VS = 136;
    const int fr = lane & 15, fq = lane >> 4;
    for (int task = bx; task < 512; task += G) {
        const int cidx = task >> 2, h = task & 3, tok0 = cidx * 128;
        const int hl = lane - 16 * h; const bool mine = (hl >= 0 && hl < 16);
        float nv[8];
#pragma unroll
        for (int j = 0; j < 8; ++j) nv[j] = mine ? norm_v[128 * h + 8 * hl + j] : 0.f;
#pragma unroll 4
        for (int r = 0; r < 16; ++r) {
            const int s = 16 * wave + r;
            const v4u raw = *(const v4u*)(PROJ + (size_t)(tok0 + s) * NAB + 512 + 8 * lane);
            float f[8]; f[0] = bflo(raw.x); f[1] = bfhi(raw.x); f[2] = bflo(raw.y); f[3] = bfhi(raw.y); f[4] = bflo(raw.z); f[5] = bfhi(raw.z); f[6] = bflo(raw.w); f[7] = bfhi(raw.w);
            float sm = ((f[0] + f[1]) + (f[2] + f[3])) + ((f[4] + f[5]) + (f[6] + f[7]));
            const float mean = wave_sum(sm) * (1.f / 512.f);
            float q = 0.f;
#pragma unroll
            for (int j = 0; j < 8; ++j) { f[j] -= mean; q += f[j] * f[j]; }
            const float rs = rsqrtf(wave_sum(q) * (1.f / 512.f) + EPS);
            if (mine) {
#pragma unroll
                for (int j = 0; j < 8; ++j) vT[(8 * hl + j) * VS + s] = (bf16)f2bf(f[j] * rs * nv[j]);
            }
        }
        __syncthreads();
        f32x4 acc[8];
#pragma unroll
        for (int d = 0; d < 8; ++d) acc[d] = (f32x4){0.f, 0.f, 0.f, 0.f};
        const int t0 = 16 * wave, kkmax = (t0 + 15) >> 5;
        for (int kk = 0; kk <= kkmax; ++kk) {
            const bf16x8 wf = *(const bf16x8*)(WST + (size_t)(h * 128 + t0 + fr) * 128 + 32 * kk + 8 * fq);
#pragma unroll
            for (int d = 0; d < 8; ++d) { const bf16x8 vf = *(const LAS bf16x8*)(vT + (16 * d + fr) * VS + 32 * kk + 8 * fq); acc[d] = mfma16(vf, wf, acc[d]); }
        }
        {
            const int t = tok0 + t0 + fr; const float zb = b_s[h * 128 + t0 + fr];
#pragma unroll
            for (int d = 0; d < 8; ++d) {
                const int col = 128 * h + 16 * d + 4 * fq;
                const v2u gu = *(const v2u*)(PROJ + (size_t)t * NAB + col);
                const float y0 = bflo(gu.x) * (acc[d][0] + zb), y1 = bfhi(gu.x) * (acc[d][1] + zb), y2 = bflo(gu.y) * (acc[d][2] + zb), y3 = bfhi(gu.y) * (acc[d][3] + zb);
                v2u w; w.x = pk2(y0, y1); w.y = pk2(y2, y3);
                *(v2u*)(YMIX + (size_t)t * D + col) = w;
            }
        }
        {
            const int tf = tok0 + 32 * h + 4 * wave; const bool halo = (tf & 2047) != 0; const int c = 8 * lane;
            float w0[8], w1[8], w2[8], pm2[8], pm1[8];
#pragma unroll
            for (int j = 0; j < 8; ++j) { w0[j] = conv_w[c + j]; w1[j] = conv_w[512 + c + j]; w2[j] = conv_w[1024 + c + j]; pm2[j] = 0.f; pm1[j] = 0.f; }
            if (halo) {
                const bf16* p2 = PROJ + (size_t)(tf - 2) * NAB + c; const bf16* p1 = PROJ + (size_t)(tf - 1) * NAB + c;
                const v4u a2 = *(const v4u*)(p2 + 1536), b2 = *(const v4u*)(p2 + 2048), a1 = *(const v4u*)(p1 + 1536), b1 = *(const v4u*)(p1 + 2048);
                pm2[0] = bflo(a2.x) * bflo(b2.x); pm2[1] = bfhi(a2.x) * bfhi(b2.x); pm2[2] = bflo(a2.y) * bflo(b2.y); pm2[3] = bfhi(a2.y) * bfhi(b2.y);
                pm2[4] = bflo(a2.z) * bflo(b2.z); pm2[5] = bfhi(a2.z) * bfhi(b2.z); pm2[6] = bflo(a2.w) * bflo(b2.w); pm2[7] = bfhi(a2.w) * bfhi(b2.w);
                pm1[0] = bflo(a1.x) * bflo(b1.x); pm1[1] = bfhi(a1.x) * bfhi(b1.x); pm1[2] = bflo(a1.y) * bflo(b1.y); pm1[3] = bfhi(a1.y) * bfhi(b1.y);
                pm1[4] = bflo(a1.z) * bflo(b1.z); pm1[5] = bfhi(a1.z) * bfhi(b1.z); pm1[6] = bflo(a1.w) * bflo(b1.w); pm1[7] = bfhi(a1.w) * bfhi(b1.w);
            }
#pragma unroll
            for (int r = 0; r < 4; ++r) {
                const bf16* pr = PROJ + (size_t)(tf + r) * NAB + c;
                const v4u g = *(const v4u*)(pr + 1024), a = *(const v4u*)(pr + 1536), x = *(const v4u*)(pr + 2048);
                float cur[8], bgv[8], y[8];
                cur[0] = bflo(a.x) * bflo(x.x); cur[1] = bfhi(a.x) * bfhi(x.x); cur[2] = bflo(a.y) * bflo(x.y); cur[3] = bfhi(a.y) * bfhi(x.y);
                cur[4] = bflo(a.z) * bflo(x.z); cur[5] = bfhi(a.z) * bfhi(x.z); cur[6] = bflo(a.w) * bflo(x.w); cur[7] = bfhi(a.w) * bfhi(x.w);
                bgv[0] = bflo(g.x); bgv[1] = bfhi(g.x); bgv[2] = bflo(g.y); bgv[3] = bfhi(g.y); bgv[4] = bflo(g.z); bgv[5] = bfhi(g.z); bgv[6] = bflo(g.w); bgv[7] = bfhi(g.w);
#pragma unroll
                for (int j = 0; j < 8; ++j) { y[j] = bgv[j] * (w0[j] * pm2[j] + w1[j] * pm1[j] + w2[j] * cur[j]); pm2[j] = pm1[j]; pm1[j] = cur[j]; }
                v4u o; o.x = pk2(y[0], y[1]); o.y = pk2(y[2], y[3]); o.z = pk2(y[4], y[5]); o.w = pk2(y[6], y[7]);
                *(v4u*)(YMIX + (size_t)(tf + r) * D + 512 + c) = o;
            }
        }
        __syncthreads();
    }
}

constexpr int PS = 264;
template <int W> __device__ __forceinline__ void pool_build(const float* X2, const float* rowss, const float* gkp, const float* shp, LAS bf16* P, int tile0, int g, int wave, int lane) {
    const int c = 256 * g + 4 * lane, trow0 = tile0 + 16 * wave, tpos0 = trow0 & 2047;
    const f32x4 gk = *(const f32x4*)(gkp + c), sh = *(const f32x4*)(shp + c);
    f32x4 ring[W];
#pragma unroll
    for (int r = -(W - 1); r < 16; ++r) {
        const int t = trow0 + r; const bool valid = (tpos0 + r) >= 0;
        f32x4 hv = (f32x4){0.f, 0.f, 0.f, 0.f};
        if (valid) { const float rs = rsqrtf(rowss[t] * (1.f / 1024.f) + EPS); const f32x4 xv = *(const f32x4*)(X2 + (size_t)t * D + c); hv = xv * rs * gk + sh; }
        ring[(r + 16) % W] = hv;
        if (r >= 0) {
            f32x4 S = ring[0];
#pragma unroll
            for (int q = 1; q < W; ++q) S += ring[q];
            const int cnt = (tpos0 + r + 1) < W ? (tpos0 + r + 1) : W;
            const f32x4 p = S * (1.f / (float)cnt) - hv;
            v2u o; o.x = pk2(p[0], p[1]); o.y = pk2(p[2], p[3]);
            *(LAS v2u*)(P + (16 * wave + r) * PS + 4 * lane) = o;
            if ((r & 3) == 3) asm volatile("" ::: "memory");
        }
    }
}
__device__ __forceinline__ void pool_phase(const float* X2, float* XO, const float* rowss4, float* rowss5, const float* gk4, const float* shift4, const float* gate4, const float* gk5,
                                           const bf16* WGT, bf16* XB, LAS unsigned char* lds, int bx, int G, int wave, int lane) {
    LAS bf16* P = (LAS bf16*)lds;
    const int fr = lane & 15, fq = lane >> 4;
    for (int task = bx; task < 512; task += G) {
        const int tile = task >> 2, g = task & 3, tile0 = tile * 128, b = tile0 >> 11;
        const float* gkp = gk4 + b * 1024; const float* shp = shift4 + (size_t)b * MODW;
        if (g == 0) pool_build<2>(X2, rowss4, gkp, shp, P, tile0, g, wave, lane);
        else if (g == 1) pool_build<4>(X2, rowss4, gkp, shp, P, tile0, g, wave, lane);
        else if (g == 2) pool_build<8>(X2, rowss4, gkp, shp, P, tile0, g, wave, lane);
        else pool_build<16>(X2, rowss4, gkp, shp, P, tile0, g, wave, lane);
        __syncthreads();
        f32x4 acc[8][2];
#pragma unroll
        for (int tb = 0; tb < 8; ++tb) { acc[tb][0] = (f32x4){0.f, 0.f, 0.f, 0.f}; acc[tb][1] = (f32x4){0.f, 0.f, 0.f, 0.f}; }
        const bf16* wbase = WGT + (size_t)(g * 256 + 32 * wave + fr) * 256 + 8 * fq;
#pragma unroll
        for (int kk = 0; kk < 8; ++kk) {
            const bf16x8 wf0 = *(const bf16x8*)(wbase + 32 * kk), wf1 = *(const bf16x8*)(wbase + 16 * 256 + 32 * kk);
#pragma unroll
            for (int tb = 0; tb < 8; ++tb) {
                const bf16x8 pf = *(const LAS bf16x8*)(P + (16 * tb + fr) * PS + 32 * kk + 8 * fq);
                acc[tb][0] = mfma16(wf0, pf, acc[tb][0]); acc[tb][1] = mfma16(wf1, pf, acc[tb][1]);
            }
        }
        const int colb = 256 * g + 32 * wave + 4 * fq;
        f32x4 gt[2], gk[2];
#pragma unroll
        for (int nb = 0; nb < 2; ++nb) { gt[nb] = *(const f32x4*)(gate4 + b * 1024 + colb + 16 * nb); gk[nb] = *(const f32x4*)(gk5 + b * 1024 + colb + 16 * nb); }
#pragma unroll
        for (int tb = 0; tb < 8; ++tb) {
            const int t = tile0 + 16 * tb + fr; float ss = 0.f;
#pragma unroll
            for (int nb = 0; nb < 2; ++nb) {
                const size_t off = (size_t)t * D + colb + 16 * nb;
                f32x4 xv = *(const f32x4*)(X2 + off); xv += gt[nb] * acc[tb][nb];
                *(f32x4*)(XO + off) = xv;
                ss += (xv[0] * xv[0] + xv[1] * xv[1]) + (xv[2] * xv[2] + xv[3] * xv[3]);
                const f32x4 y = xv * gk[nb]; v2u o; o.x = pg8::cvt_pk_bf16(y[0], y[1]); o.y = pg8::cvt_pk_bf16(y[2], y[3]);
                *(v2u*)(XB + off) = o;
            }
            ss += __shfl_xor(ss, 16); ss += __shfl_xor(ss, 32);
            if (fq == 0) unsafeAtomicAdd(rowss5 + t, ss);
        }
        __syncthreads();
    }
}

__device__ __forceinline__ int lane_of(int& t) { asm volatile("" : "+v"(t)); return t & 63; }
struct Args { const float* in[16]; float* out; unsigned char* ws; int never; int pad; };
typedef const __attribute__((address_space(4))) Args* KArgs;
__device__ __forceinline__ KArgs kargs() { KArgs p = (KArgs)__builtin_amdgcn_kernarg_segment_ptr(); asm volatile("" : "+s"(p)); return p; }

__global__ void __launch_bounds__(512, 2) fwd_mega(Args a) {
    extern __shared__ __attribute__((aligned(16))) unsigned char lds_raw[];
    LAS unsigned char* lds = (LAS unsigned char*)lds_raw;
    int tid_l = threadIdx.x; asm volatile("" : "+v"(tid_l));
#define tid ((int)tid_l)
#define lane (lane_of(tid_l))
    const int wave = __builtin_amdgcn_readfirstlane(tid_l >> 6);
    const int G = gridDim.x, bx = blockIdx.x;
    const int gw = bx * 8 + wave, NGW = G * 8;
    for (int u = tid; u < (LDS_BYTES - LDSCTL_OFF) / 4; u += 512) ((LAS unsigned*)(lds + LDSCTL_OFF))[u] = 0u;
    __syncthreads();
    XcdBarrier bar = xcd_barrier_post((unsigned*)(kargs()->ws + WS_CTL) + CW_BAR, (volatile LAS unsigned*)(lds + MISC_OFF) + 8);
    if (kargs()->never) cg::this_grid().sync();
#define GRID_BAR() xcd_barrier(bar)
#define IN_(i) (kargs()->in[i])
#define WSP(off) (kargs()->ws + (off))
#define x_in IN_(0)
#define c_in IN_(1)
#define norm_g IN_(2)
#define w_mod IN_(3)
#define b_mod IN_(4)
#define w_ffn_in IN_(5)
#define w_ffn_out IN_(6)
#define ab_w_in IN_(7)
#define ab_norm_v IN_(8)
#define ab_w_s IN_(9)
#define ab_b_s IN_(10)
#define ab_conv_w IN_(11)
#define ab_w_out IN_(12)
#define pool_w_grp IN_(13)
#define pool_scale IN_(14)
#define final_g IN_(15)
#define out (kargs()->out)
#define MOD ((float*)WSP(WS_MOD))
#define GK ((float*)WSP(WS_GK))
#define GATE ((float*)WSP(WS_GATE))
#define BIAS ((float*)WSP(WS_BIAS))
#define ROWSS ((float*)WSP(WS_ROWSS))
#define WST ((bf16*)WSP(WS_WS))
#define WGT ((bf16*)WSP(WS_WGT))
#define WIN ((bf16*)WSP(WS_WIN))
#define WOUT ((bf16*)WSP(WS_WOUT))
#define ABIN ((bf16*)WSP(WS_ABIN))
#define ABOUT ((bf16*)WSP(WS_ABOUT))
#define XB ((bf16*)WSP(WS_XB))
#define YMIX ((bf16*)WSP(WS_YMIX))
#define ACT ((bf16*)WSP(WS_ACT))
#define X2 ((float*)WSP(WS_X2))

    {
        if (bx < 144) mod_task(c_in, w_mod, b_mod, MOD, (LAS float*)lds, bx, tid, wave, lane);
        LAS float* scr = (LAS float*)(lds + wave * 16384);
        constexpr int I_IN = 16 * 176, I_OUT = 44 * 32, I_ABIN = 16 * 80, I_ABOUT = 16 * 32, I_PG = 4 * 8;
        constexpr int NITEMS = 4 * I_IN + 4 * I_OUT + I_ABIN + I_ABOUT + 4 * I_PG;
        for (int it = gw; it < NITEMS; it += NGW) {
            int r = it;
            if (r < 4 * I_IN) { const int q = r / I_IN; r -= q * I_IN; transpose_item(w_ffn_in + (size_t)q * D * NIN, D, NIN, WIN + (size_t)q * NIN * D, 1, scr, r, lane); continue; } r -= 4 * I_IN;
            if (r < 4 * I_OUT) { const int q = r / I_OUT; r -= q * I_OUT; transpose_item(w_ffn_out + (size_t)q * FF * D, FF, D, WOUT + (size_t)q * D * FF, 0, scr, r, lane); continue; } r -= 4 * I_OUT;
            if (r < I_ABIN) { transpose_item(ab_w_in, D, NAB, ABIN, 0, scr, r, lane); continue; } r -= I_ABIN;
            if (r < I_ABOUT) { transpose_item(ab_w_out, D, D, ABOUT, 0, scr, r, lane); continue; } r -= I_ABOUT;
            { const int q = r / I_PG; r -= q * I_PG; transpose_item(pool_w_grp + (size_t)q * 65536, 256, 256, WGT + (size_t)q * 65536, 0, scr, r, lane); }
        }
        for (int i = bx * 512 + tid; i < 4 * 128 * 128; i += G * 512) { const int s = i & 127, t = (i >> 7) & 127; WST[i] = (s <= t) ? (bf16)f2bf(ab_w_s[i]) : (bf16)0; }
        for (int i = bx * 512 + tid; i < 6 * T; i += G * 512) ROWSS[T + i] = 0.f;
    }
    GRID_BAR();
    {
        for (int idx = bx * 512 + tid; idx < 6 * 8 * 1024; idx += G * 512) {
            const int i = idx >> 13, b = (idx >> 10) & 7, k = idx & 1023, l = i / 3, s = i - 3 * l;
            const float* mb = MOD + (size_t)(l * 8 + b) * MODW + s * 3072;
            GK[idx] = norm_g[i * 1024 + k] * (1.f + mb[1024 + k]);
            float g = mb[2048 + k] * (s == 1 ? 1.f : 0.5f); if (i == 4) g *= pool_scale[k];
            GATE[idx] = g;
        }
        constexpr int BT_IN = NIN / 16, BT_AB = NAB / 16, NBT = 4 * BT_IN + BT_AB;
        const int fr = lane & 15, fq = lane >> 4;
        for (int tk = gw; tk < NBT; tk += NGW) {
            int g, r0, N, i; const bf16* Bt;
            if (tk < 4 * BT_IN) { g = tk / BT_IN; r0 = (tk - g * BT_IN) * 16; Bt = WIN + (size_t)g * NIN * D; N = NIN; i = (g >> 1) * 3 + (g & 1) * 2; }
            else { g = 4; r0 = (tk - 4 * BT_IN) * 16; Bt = ABIN; N = NAB; i = 1; }
            const int l = i / 3, s = i - 3 * l;
            const float* shp = MOD + (size_t)(l * 8 + (fr & 7)) * MODW + s * 3072 + 8 * fq;
            const bf16* ap = Bt + (size_t)(r0 + fr) * D + 8 * fq;
            f32x4 acc = (f32x4){0.f, 0.f, 0.f, 0.f};
#pragma unroll 4
            for (int kk = 0; kk < 32; ++kk) {
                const bf16x8 av = *(const bf16x8*)(ap + 32 * kk);
                const f32x4 s0 = *(const f32x4*)(shp + 32 * kk), s1 = *(const f32x4*)(shp + 32 * kk + 4);
                float hi[8], lo[8];
#pragma unroll
                for (int j = 0; j < 4; ++j) { hi[j] = __uint_as_float(f2bf(s0[j]) << 16); lo[j] = s0[j] - hi[j]; hi[4 + j] = __uint_as_float(f2bf(s1[j]) << 16); lo[4 + j] = s1[j] - hi[4 + j]; }
                acc = mfma16(av, pack8(hi), acc); acc = mfma16(av, pack8(lo), acc);
            }
            if (fr < 8) *(f32x4*)(BIAS + (size_t)g * BIAS_STRIDE_F + (size_t)fr * N + r0 + 4 * fq) = acc;
        }
        for (int m = gw; m < T; m += NGW) {
            const int b = m >> 11; const float* xr = x_in + (size_t)m * D; const float* mb = MOD + (size_t)b * MODW + 1024;
            f32x4 v[4]; float ss = 0.f;
#pragma unroll
            for (int j = 0; j < 4; ++j) { v[j] = *(const f32x4*)(xr + 4 * lane + 256 * j); ss += (v[j][0] * v[j][0] + v[j][1] * v[j][1]) + (v[j][2] * v[j][2] + v[j][3] * v[j][3]); }
            ss = wave_sum(ss); if (lane == 0) ROWSS[m] = ss;
#pragma unroll
            for (int j = 0; j < 4; ++j) { const int c = 4 * lane + 256 * j; const f32x4 g = *(const f32x4*)(norm_g + c), sc = *(const f32x4*)(mb + c); const f32x4 y = v[j] * g * (sc + 1.f);
                v2u o; o.x = pk2(y[0], y[1]); o.y = pk2(y[2], y[3]); *(v2u*)(XB + (size_t)m * D + c) = o; }
        }
    }
    GRID_BAR();
#pragma clang loop unroll(disable)
    for (int f = 0; f < 4; ++f) {
        const int l = f >> 1, i = 3 * l + 2 * (f & 1);
        {
            pg8::Gemm g{XB, WIN + (size_t)f * NIN * D, T, NIN, D}; pg8::StaticOrder S; S.init(T, NIN, G, bx);
            EpiSwiglu E{ACT, ROWSS + (size_t)i * T, BIAS + (size_t)f * BIAS_STRIDE_F};
            pg8::gemm_phase<EpiSwiglu, pg8::StaticOrder, true, true>(lds, g, S, E);
        }
        GRID_BAR();
        {
            pg8::Gemm g{ACT, WOUT + (size_t)f * D * FF, T, D, FF}; pg8::StaticOrder S; S.init(T, D, G, bx);
            EpiResid E{f == 0 ? x_in : out, f == 2 ? X2 : out, GATE + (size_t)i * 8192, ROWSS + (size_t)(i + 1) * T, f < 2 ? GK + (size_t)(i + 1) * 8192 : nullptr, XB};
            pg8::gemm_phase<EpiResid, pg8::StaticOrder, true, true>(lds, g, S, E);
        }
        GRID_BAR();
        if (f == 0) {
            {
                pg8::Gemm g{XB, ABIN, T, NAB, D}; pg8::StaticOrder S; S.init(T, NAB, G, bx);
                EpiProj E{ACT, ROWSS + (size_t)1 * T, BIAS + (size_t)4 * BIAS_STRIDE_F};
                pg8::gemm_phase<EpiProj, pg8::StaticOrder, true, true>(lds, g, S, E);
            }
            GRID_BAR();
            mid_phase(ACT, YMIX, WST, ab_norm_v, ab_b_s, ab_conv_w, lds, bx, G, wave, lane);
            GRID_BAR();
            {
                pg8::Gemm g{YMIX, ABOUT, T, D, D}; pg8::StaticOrder S; S.init(T, D, G, bx);
                EpiResid E{out, out, GATE + (size_t)1 * 8192, ROWSS + (size_t)2 * T, GK + (size_t)2 * 8192, XB};
                pg8::gemm_phase<EpiResid, pg8::StaticOrder, true, true>(lds, g, S, E);
            }
            GRID_BAR();
        } else if (f == 2) {
            pool_phase(X2, out, ROWSS + (size_t)4 * T, ROWSS + (size_t)5 * T, GK + (size_t)4 * 8192, MOD + (size_t)8 * MODW + 3072, GATE + (size_t)4 * 8192, GK + (size_t)5 * 8192,
                       WGT, XB, lds, bx, G, wave, lane);
            GRID_BAR();
        }
    }
    for (int m = gw; m < T; m += NGW) {
        const float rs = rsqrtf(ROWSS[(size_t)6 * T + m] * (1.f / 1024.f) + EPS);
#pragma unroll
        for (int j = 0; j < 4; ++j) { const int c = 4 * lane + 256 * j; f32x4 v = *(const f32x4*)(out + (size_t)m * D + c); const f32x4 g = *(const f32x4*)(final_g + c); v = v * rs * g; *(f32x4*)(out + (size_t)m * D + c) = v; }
    }
}

#undef tid
#undef lane
#undef GRID_BAR
#undef IN_
#undef WSP
#undef x_in
#undef c_in
#undef norm_g
#undef w_mod
#undef b_mod
#undef w_ffn_in
#undef w_ffn_out
#undef ab_w_in
#undef ab_norm_v
#undef ab_w_s
#undef ab_b_s
#undef ab_conv_w
#undef ab_w_out
#undef pool_w_grp
#undef pool_scale
#undef final_g
#undef out
#undef MOD
#undef GK
#undef GATE
#undef BIAS
#undef ROWSS
#undef WST
#undef WGT
#undef WIN
#undef WOUT
#undef ABIN
#undef ABOUT
#undef XB
#undef YMIX
#undef ACT
#undef X2

extern "C" void kernel_launch(void* const* d_in, const int* in_sizes, int n_in, void* d_out, int out_size, void* d_ws, size_t ws_size, hipStream_t stream) {
    static int grid = 0;
    if (grid == 0) {
        if (n_in != 16 || in_sizes[0] != T * D || out_size != T * D || ws_size < WS_END) { fprintf(stderr, "kernel_launch: unexpected shapes (n_in %d, in0 %d, out %d, ws %zu)\n", n_in, n_in > 0 ? in_sizes[0] : -1, out_size, ws_size); grid = -1; return; }
        int dev = 0, cus = 0, per_cu = 0;
        if (hipGetDevice(&dev) != hipSuccess || hipDeviceGetAttribute(&cus, hipDeviceAttributeMultiprocessorCount, dev) != hipSuccess) { grid = -1; return; }
        if (hipFuncSetAttribute((const void*)fwd_mega, hipFuncAttributeMaxDynamicSharedMemorySize, LDS_BYTES) != hipSuccess) { fprintf(stderr, "kernel_launch: hipFuncSetAttribute failed\n"); grid = -1; return; }
        if (hipOccupancyMaxActiveBlocksPerMultiprocessor(&per_cu, (const void*)fwd_mega, 512, LDS_BYTES) != hipSuccess || per_cu < 1) { fprintf(stderr, "kernel_launch: occupancy query says %d blocks per CU\n", per_cu); per_cu = 1; }
        (void)hipGetLastError();
        grid = cus;
    }
    if (grid < 0) return;
    (void)hipMemsetAsync((char*)d_ws + WS_CTL, 0, CTL_ZERO_BYTES, stream);
    Args a{};
    for (int i = 0; i < 16; ++i) a.in[i] = (const float*)d_in[i];
    a.out = (float*)d_out; a.ws = (unsigned char*)d_ws; a.never = 0; a.pad = 0;
    void* args[] = {&a};
    const hipError_t e = hipLaunchCooperativeKernel((const void*)fwd_mega, dim3(grid), dim3(512), args, LDS_BYTES, stream);
    if (e != hipSuccess) fprintf(stderr, "kernel_launch: cooperative launch failed: %s (grid %d)\n", hipGetErrorString(e), grid);
}
```

```cpp
#include <hip/hip_runtime.h>
#include <hip/hip_cooperative_groups.h>
#include <cstdio>
#include <cstdint>
namespace cg = cooperative_groups;
namespace pg8 {
#define PG8_LAS __attribute__((address_space(3)))
typedef unsigned short bf16_t;
typedef short bf16x8 __attribute__((ext_vector_type(8)));
typedef float f32x4 __attribute__((ext_vector_type(4)));
typedef unsigned u32x4 __attribute__((ext_vector_type(4)));
constexpr int BM = 256, BK = 64, HALF = 128, HTB = HALF * BK * 2  , STAGE_BYTES = 8 * HTB, NXCD = 8, WGM = 8;

__host__ __device__ __forceinline__ int lds_byte(int r, int c) { const int st = (r >> 4) * 2 + (c >> 5), rr = r & 15, cc = c & 31, ob = rr * 64 + cc * 2; return st * 1024 + (ob ^ (((ob >> 9) & 1) << 5)); }
__host__ __device__ __forceinline__ void stage_rc(int b, int& R, int& C) { const int st = b / 1024, sb = b % 1024, swz = sb ^ (((sb >> 9) & 1) << 5); R = (st >> 1) * 16 + swz / 64; C = (st & 1) * 32 + (swz % 64) / 2; }
__host__ __device__ __forceinline__ int perm32(int rho) { const int n = rho >> 4, i = rho & 15; return 8 * (i >> 2) + 4 * n + (i & 3); }

struct Unit { int pm, pn; };
struct Gemm { const bf16_t* A; const bf16_t* Bt; int M, N, K; };

struct StaticOrder {
    int nM, nN, nwg, G, c;
    __host__ __device__ void init(int M, int N, int G_, int c_) { nM = M / BM; nN = N / BM; nwg = nM * nN; G = G_; c = c_; }
    __host__ __device__ bool next(int i, Unit& u) const {
        const long L = (long)i * G + c; if (L >= nwg) return false;
        int wgid = (int)L; { const int q = nwg / NXCD, r = nwg % NXCD, xcd = wgid % NXCD, off = wgid / NXCD; wgid = (xcd < r ? xcd * (q + 1) : r * (q + 1) + (xcd - r) * q) + off; }
        const int nig = WGM * nN, gid = wgid / nig, fm = gid * WGM, gsz = (nM - fm) < WGM ? (nM - fm) : WGM;
        u.pm = fm + ((wgid % nig) % gsz); u.pn = (wgid % nig) / gsz; return true;
    }
    __device__ __forceinline__ void a_ready(const Unit&) const {}
    __device__ __forceinline__ void done(const Unit&) const {}
};

__device__ __forceinline__ unsigned cvt_pk_bf16(float lo, float hi) { unsigned r; asm volatile("v_cvt_pk_bf16_f32 %0, %1, %2" : "=v"(r) : "v"(lo), "v"(hi)); return r; }
template <class Epi, class Sched, bool ALIGN_EPI = false, bool SP2 = false>
__device__ __forceinline__ void gemm_phase(PG8_LAS unsigned char* lds, const Gemm g, const Sched& S, const Epi& E) {
    int tid_l = threadIdx.x; asm volatile("" : "+v"(tid_l));
    const int tid = tid_l, wid = __builtin_amdgcn_readfirstlane(tid >> 6), lane = tid & 63, wr = wid >> 2, wc = wid & 3, fr = lane & 15, fq = lane >> 4;
    const int K = g.K, nt = K / BK;
    unsigned voffA[2], voffB[2];
#pragma unroll
    for (int i = 0; i < 2; ++i) { int R, C; stage_rc(tid * 16 + i * 8192, R, C); const int Rb = Epi::PERM ? ((R & ~31) + perm32(R & 31)) : R;
        voffA[i] = (unsigned)(R * K + C) * 2u; voffB[i] = (unsigned)(Rb * K + C) * 2u; }
    const size_t kstep = (size_t)(BK * 2);
    const size_t hstep = (size_t)HALF * K * 2;
    const size_t tstep = 2 * hstep;
    const unsigned ldsw = (unsigned)wid * 1024u;
    const int aoff = lds_byte(wr * 64 + fr, fq * 8), boff = lds_byte(wc * 32 + fr, fq * 8);
#define PG8_SA(b, h) (((b) * 2 + (h)) * HTB)
#define PG8_SB(b, h) ((4 + (b) * 2 + (h)) * HTB)
#define PG8_STAGE(bufoff, gbase, voff) do { _Pragma("unroll") for (int _i = 0; _i < 2; ++_i) \
        __builtin_amdgcn_global_load_lds((const unsigned*)((const char*)(gbase) + (voff)[_i]), (PG8_LAS unsigned*)(lds + (bufoff) + ldsw + _i * 8192), 16, 0, 0); } while (0)
#define PG8_LDA(dst, b, h) do { _Pragma("unroll") for (int m = 0; m < 4; ++m) _Pragma("unroll") for (int k = 0; k < 2; ++k) dst[m][k] = *(const PG8_LAS bf16x8*)(lds + PG8_SA(b, h) + aoff + m * 2048 + k * 1024); } while (0)
#define PG8_LDB(dst, b, h) do { _Pragma("unroll") for (int n = 0; n < 2; ++n) _Pragma("unroll") for (int k = 0; k < 2; ++k) dst[n][k] = *(const PG8_LAS bf16x8*)(lds + PG8_SB(b, h) + boff + n * 2048 + k * 1024); } while (0)
#define PG8_MMA(ai, bj, At, Bt) do { __builtin_amdgcn_s_setprio(1); _Pragma("unroll") for (int m = 0; m < 4; ++m) _Pragma("unroll") for (int n = 0; n < 2; ++n) _Pragma("unroll") for (int k = 0; k < 2; ++k) \
        acc[ai][bj][m][n] = __builtin_amdgcn_mfma_f32_16x16x32_bf16(Bt[n][k], At[m][k], acc[ai][bj][m][n], 0, 0, 0); __builtin_amdgcn_s_setprio(0); } while (0)
#define PG8_WAIT_V(n) asm volatile("s_waitcnt vmcnt(" #n ")" ::: "memory")
#define PG8_WAIT_L(n) asm volatile("s_waitcnt lgkmcnt(" #n ")" ::: "memory")
#define PG8_BAR __builtin_amdgcn_s_barrier()
#define PG8_SCHED __builtin_amdgcn_sched_barrier(0)
    Unit cur, nxt; int ui = 0;
    if (!S.next(0, cur)) return;
    f32x4 acc[2][2][4][2];
#pragma unroll
    for (int a = 0; a < 2; ++a)
#pragma unroll
        for (int b = 0; b < 2; ++b)
#pragma unroll
            for (int m = 0; m < 4; ++m)
#pragma unroll
                for (int n = 0; n < 2; ++n) acc[a][b][m][n] = (f32x4){0.f, 0.f, 0.f, 0.f};
    bf16x8 At[4][2], B0[2][2], B1[2][2];
    const char* cA = (const char*)g.A + (size_t)cur.pm * tstep; const char* cB = (const char*)g.Bt + (size_t)cur.pn * tstep;
    S.a_ready(cur);
    if constexpr (SP2) {
        PG8_STAGE(PG8_SB(0, 0), cB, voffB); PG8_STAGE(PG8_SB(0, 1), cB + hstep, voffB); PG8_STAGE(PG8_SA(0, 0), cA, voffA); PG8_STAGE(PG8_SA(0, 1), cA + hstep, voffA);
        if (wr == 1) PG8_BAR;
        PG8_WAIT_V(2); PG8_BAR;
        PG8_STAGE(PG8_SB(1, 0), cB + kstep, voffB); PG8_STAGE(PG8_SA(1, 0), cA + kstep, voffA); PG8_STAGE(PG8_SB(1, 1), cB + hstep + kstep, voffB);
        PG8_WAIT_V(6); PG8_BAR;
    } else {
        PG8_STAGE(PG8_SB(0, 0), cB, voffB); PG8_STAGE(PG8_SA(0, 0), cA, voffA); PG8_STAGE(PG8_SB(0, 1), cB + hstep, voffB); PG8_STAGE(PG8_SA(0, 1), cA + hstep, voffA);
        if (wr == 1) PG8_BAR;
        PG8_WAIT_V(4); PG8_BAR;
        PG8_STAGE(PG8_SB(1, 0), cB + kstep, voffB); PG8_STAGE(PG8_SA(1, 0), cA + kstep, voffA); PG8_STAGE(PG8_SB(1, 1), cB + hstep + kstep, voffB);
        PG8_WAIT_V(6); PG8_BAR;
    }
    for (;;) {
        const bool has_next = S.next(ui + 1, nxt);
        const char* nA = has_next ? (const char*)g.A + (size_t)nxt.pm * tstep : cA; const char* nB = has_next ? (const char*)g.Bt + (size_t)nxt.pn * tstep : cB;
        for (int t = 0; t < nt; t += 2) {
            const bool last = (t == nt - 2);
            const char* a1 = cA + (size_t)(t + 1) * kstep;
            const char* a2 = last ? nA : cA + (size_t)(t + 2) * kstep; const char* b2 = last ? nB : cB + (size_t)(t + 2) * kstep;
            const char* a3 = a2 + kstep; const char* b3 = b2 + kstep;
            if (last && has_next) S.a_ready(nxt);
            if constexpr (SP2) {
            PG8_LDB(B0, 0, 0); PG8_LDB(B1, 0, 1); PG8_SCHED; PG8_LDA(At, 0, 0); PG8_STAGE(PG8_SA(1, 1), a1 + hstep, voffA);
            PG8_WAIT_V(8); PG8_WAIT_L(0); PG8_BAR; PG8_MMA(0, 0, At, B0); PG8_MMA(0, 1, At, B1); PG8_BAR; PG8_SCHED;
            PG8_LDA(At, 0, 1); PG8_STAGE(PG8_SB(0, 0), b2, voffB); PG8_STAGE(PG8_SB(0, 1), b2 + hstep, voffB); PG8_STAGE(PG8_SA(0, 0), a2, voffA);
            PG8_WAIT_V(8); PG8_WAIT_L(0); PG8_BAR; PG8_MMA(1, 0, At, B0); PG8_MMA(1, 1, At, B1); PG8_BAR; PG8_SCHED;
            PG8_LDB(B0, 1, 0); PG8_LDB(B1, 1, 1); PG8_SCHED; PG8_LDA(At, 1, 0); PG8_STAGE(PG8_SA(0, 1), a2 + hstep, voffA);
            PG8_WAIT_V(8); PG8_WAIT_L(0); PG8_BAR; PG8_MMA(0, 0, At, B0); PG8_MMA(0, 1, At, B1); PG8_BAR; PG8_SCHED;
            PG8_LDA(At, 1, 1); PG8_STAGE(PG8_SB(1, 0), b3, voffB); PG8_STAGE(PG8_SB(1, 1), b3 + hstep, voffB); PG8_STAGE(PG8_SA(1, 0), a3, voffA);
            PG8_WAIT_V(8); PG8_WAIT_L(0); PG8_BAR; PG8_MMA(1, 0, At, B0); PG8_MMA(1, 1, At, B1); PG8_BAR; PG8_SCHED;
            } else {
            PG8_LDB(B0, 0, 0); PG8_SCHED; PG8_LDA(At, 0, 0); PG8_STAGE(PG8_SA(1, 1), a1 + hstep, voffA);
            PG8_WAIT_L(8); PG8_BAR; PG8_WAIT_L(0); PG8_MMA(0, 0, At, B0); PG8_BAR; PG8_SCHED;
            PG8_LDB(B1, 0, 1); PG8_STAGE(PG8_SB(0, 0), b2, voffB);
            PG8_BAR; PG8_WAIT_L(0); PG8_MMA(0, 1, At, B1); PG8_BAR;
            PG8_LDA(At, 0, 1); PG8_STAGE(PG8_SA(0, 0), a2, voffA);
            PG8_BAR; PG8_WAIT_L(0); PG8_MMA(1, 0, At, B0); PG8_BAR; PG8_SCHED;
            PG8_STAGE(PG8_SB(0, 1), b2 + hstep, voffB);
            PG8_WAIT_V(6); PG8_BAR; PG8_MMA(1, 1, At, B1); PG8_BAR;
            PG8_LDB(B0, 1, 0); PG8_SCHED; PG8_LDA(At, 1, 0); PG8_STAGE(PG8_SA(0, 1), a2 + hstep, voffA);
            PG8_WAIT_L(8); PG8_BAR; PG8_WAIT_L(0); PG8_MMA(0, 0, At, B0); PG8_BAR; PG8_SCHED;
            PG8_LDB(B1, 1, 1); PG8_STAGE(PG8_SB(1, 0), b3, voffB);
            PG8_BAR; PG8_WAIT_L(0); PG8_MMA(0, 1, At, B1); PG8_BAR;
            PG8_LDA(At, 1, 1); PG8_STAGE(PG8_SA(1, 0), a3, voffA);
            PG8_BAR; PG8_WAIT_L(0); PG8_MMA(1, 0, At, B0); PG8_BAR; PG8_SCHED;
            PG8_STAGE(PG8_SB(1, 1), b3 + hstep, voffB);
            PG8_WAIT_V(6); PG8_BAR; PG8_MMA(1, 1, At, B1); PG8_BAR;
            }
        }
        if constexpr (ALIGN_EPI) { if (wr == 0) PG8_BAR; }
        if constexpr (!Epi::AFTER_DRAIN) { E(acc, cur, wr, wc, fr, fq); if constexpr (Epi::TWICE) { asm volatile("" ::: "memory"); E.again(acc, cur, wr, wc, fr, fq); } S.done(cur); }
        if (!has_next) break;
#pragma unroll
        for (int a = 0; a < 2; ++a)
#pragma unroll
            for (int b = 0; b < 2; ++b)
#pragma unroll
                for (int m = 0; m < 4; ++m)
#pragma unroll
                    for (int n = 0; n < 2; ++n) acc[a][b][m][n] = (f32x4){0.f, 0.f, 0.f, 0.f};
        cur = nxt; cA = nA; cB = nB; ++ui;
        if constexpr (ALIGN_EPI) { if (wr == 1) PG8_BAR; }
    }
    PG8_WAIT_V(0);
    if constexpr (!ALIGN_EPI) { if (wr == 0) PG8_BAR; }
    PG8_BAR;
    if constexpr (Epi::AFTER_DRAIN) { E.fused(acc, cur, wr, wc, fr, fq, lds, wid, lane); S.done(cur); }
#undef PG8_SA
#undef PG8_SB
#undef PG8_STAGE
#undef PG8_LDA
#undef PG8_LDB
#undef PG8_MMA
#undef PG8_WAIT_V
#undef PG8_WAIT_L
#undef PG8_BAR
#undef PG8_SCHED
}
}
#define GAS __attribute__((address_space(1)))
#define LAS __attribute__((address_space(3)))
typedef unsigned short bf16;
typedef unsigned v4u __attribute__((ext_vector_type(4)));
typedef unsigned v2u __attribute__((ext_vector_type(2)));
typedef float f32x4 __attribute__((ext_vector_type(4)));
typedef short bf16x8 __attribute__((ext_vector_type(8)));
#define LDS_WAIT() asm volatile("s_waitcnt lgkmcnt(0)" ::: "memory")
__device__ __forceinline__ unsigned f2bf(float f) { unsigned u = __builtin_bit_cast(unsigned, f); return (u + 0x7fffu + ((u >> 16) & 1u)) >> 16; }
__device__ __forceinline__ unsigned pk2(float lo, float hi) { return f2bf(lo) | (f2bf(hi) << 16); }
#define XB_TMO      128
#define XB_XCNT(j)  (256  + 64 * (j))
#define XB_XSUB(j)  (1280 + 64 * (j))
#define XB_XGEN(j)  (2304 + 64 * (j))
#define XB_TOP      3328
#define XB_TOPGEN   3392
#define XCD_BAR_WORDS 3456
#define XB_SPIN_CAP (1u << 18)

__device__ __forceinline__ unsigned xb_ld(unsigned* p)              { return __hip_atomic_load(p, __ATOMIC_RELAXED, __HIP_MEMORY_SCOPE_AGENT); }
__device__ __forceinline__ unsigned xb_add(unsigned* p, unsigned v) { return __hip_atomic_fetch_add(p, v, __ATOMIC_RELAXED, __HIP_MEMORY_SCOPE_AGENT); }
__device__ __forceinline__ unsigned xb_xcc_id() { return (unsigned)__builtin_amdgcn_s_getreg((3 << 11) | 20) & 0xFu; }
#define XB_SPIN(cond, bar) do { unsigned _sp = 0; while (cond) { __builtin_amdgcn_s_sleep(1); \
    if ((++_sp & 255u) == 0u) { if (xb_ld(&(bar)[XB_TMO])) break; if (_sp > XB_SPIN_CAP) { atomicAdd(&(bar)[XB_TMO], 1u); break; } } } } while (0)

struct XcdBarrier {
    unsigned* bar; unsigned x;
    volatile LAS unsigned* st;
};

__device__ __forceinline__ XcdBarrier xcd_barrier_post(unsigned* bar, volatile LAS unsigned* st) {
    XcdBarrier b; b.bar = bar; b.x = xb_xcc_id(); b.st = st;
    if (threadIdx.x == 0) (void)xb_add(&bar[XB_XCNT(b.x)], 1u);
    return b;
}
__device__ __forceinline__ void xcd_barrier_complete(unsigned* bar, unsigned x, unsigned& nloc, unsigned& nx) {
    const unsigned G = gridDim.x * gridDim.y * gridDim.z;
    unsigned sum, cnt, mine, sp = 0u;
    for (;;) {
        sum = 0u; cnt = 0u; mine = 0u;
#pragma unroll
        for (unsigned j = 0; j < 16; ++j) { const unsigned c = xb_ld(&bar[XB_XCNT(j)]); sum += c; cnt += (c > 0u) ? 1u : 0u; mine = (j == x) ? c : mine; }
        if (sum == G) break;
        __builtin_amdgcn_s_sleep(1);
        if ((++sp & 255u) == 0u) { if (xb_ld(&bar[XB_TMO])) break; if (sp > XB_SPIN_CAP) { atomicAdd(&bar[XB_TMO], 1u); break; } }
    }
    nloc = mine > 0u ? mine : 1u; nx = cnt > 0u ? cnt : 1u;
}

__device__ __forceinline__ void xcd_barrier(const XcdBarrier& b) {
    asm volatile("s_waitcnt vmcnt(0)" ::: "memory");
    __syncthreads();
    if (threadIdx.x == 0) {
        unsigned* bar = b.bar;
        __builtin_amdgcn_s_waitcnt(0);
        unsigned nloc = b.st[0], nx = b.st[1];
        if (nloc == 0u) { xcd_barrier_complete(bar, b.x, nloc, nx); b.st[0] = nloc; b.st[1] = nx; }
        const unsigned old = xb_add(&bar[XB_XSUB(b.x)], 1u);
        const unsigned gen = old / nloc;
        if (old + 1u == (gen + 1u) * nloc) {
            __builtin_amdgcn_fence(__ATOMIC_RELEASE, "agent");
            asm volatile("s_waitcnt vmcnt(0)" ::: "memory");
            const unsigned og = xb_add(&bar[XB_TOP], 1u);
            const unsigned tg = og / nx;
            if (og + 1u == (tg + 1u) * nx) xb_add(&bar[XB_TOPGEN], 1u);
            else XB_SPIN(xb_ld(&bar[XB_TOPGEN]) == tg, bar);
            __builtin_amdgcn_fence(__ATOMIC_ACQUIRE, "agent");
            xb_add(&bar[XB_XGEN(b.x)], 1u);
            asm volatile("s_waitcnt vmcnt(0)" ::: "memory");
        } else {
            XB_SPIN(xb_ld(&bar[XB_XGEN(b.x)]) == gen, bar);
            __builtin_amdgcn_fence(__ATOMIC_ACQUIRE, "agent");
            asm volatile("s_waitcnt vmcnt(0)" ::: "memory");
        }
    }
    __syncthreads();
}


constexpr int T = 16384, D = 1024, FF = 2816, NIN = 5632, NAB = 2560, MODW = 9216;
constexpr float EPS = 1e-6f;
constexpr size_t MiB = 1u << 20;
constexpr size_t WS_CTL = 0, CTL_ZERO_BYTES = 64 * 1024;
constexpr int CW_BAR = 1024;
constexpr size_t WS_MOD = 1 * MiB;
constexpr size_t WS_GK = 2 * MiB;
constexpr size_t WS_GATE = 2 * MiB + 256 * 1024;
constexpr size_t WS_BIAS = 3 * MiB;
constexpr size_t BIAS_STRIDE_F = 65536;
constexpr size_t WS_ROWSS = 5 * MiB;
constexpr size_t WS_WS = 6 * MiB;
constexpr size_t WS_WGT = 6 * MiB + 512 * 1024;
constexpr size_t WS_HALOP = 7 * MiB;
constexpr int CW_GRP = 8192;
constexpr size_t WS_WIN = 8 * MiB;
constexpr size_t WS_WOUT = 52 * MiB;
constexpr size_t WS_ABIN = 74 * MiB;
constexpr size_t WS_ABOUT = 79 * MiB;
constexpr size_t WS_XB = 82 * MiB;
constexpr size_t WS_YMIX = 114 * MiB;
constexpr size_t WS_ACT = 146 * MiB;
constexpr size_t WS_X2 = 236 * MiB;
constexpr size_t WS_END = 300 * MiB;

constexpr int RING_BYTES = 131072, LDSCTL_OFF = RING_BYTES, MISC_OFF = LDSCTL_OFF + 320, LDS_BYTES = 147456;

__device__ __forceinline__ float wave_sum(float v) {
#pragma unroll
    for (int o = 1; o < 64; o <<= 1) v += __shfl_xor(v, o);
    return v;
}
__device__ __forceinline__ float bflo(unsigned u) { return __uint_as_float(u << 16); }
__device__ __forceinline__ float bfhi(unsigned u) { return __uint_as_float(u & 0xffff0000u); }
__device__ __forceinline__ float silu_f(float x) { return x * __builtin_amdgcn_rcpf(1.f + __builtin_amdgcn_exp2f(-1.44269504f * x)); }
__device__ __forceinline__ float gelu_tanh_f(float x) { const float u = 0.7978845608f * (x + 0.044715f * x * x * x); return x * __builtin_amdgcn_rcpf(1.f + __builtin_amdgcn_exp2f(-2.88539008f * u)); }
__device__ __forceinline__ f32x4 mfma16(bf16x8 a, bf16x8 b, f32x4 c) { return __builtin_amdgcn_mfma_f32_16x16x32_bf16(a, b, c, 0, 0, 0); }

#ifndef PROBE_SWIGLU2
#define PROBE_SWIGLU2 0
#endif
#ifndef PROBE_RESID2
#define PROBE_RESID2 0
#endif
struct EpiSwiglu {
    static constexpr bool PERM = true, AFTER_DRAIN = false, TWICE = PROBE_SWIGLU2;
    bf16* O; const float* rowss; const float* bias;
    __device__ __forceinline__ void again(const f32x4 (&acc)[2][2][4][2], const pg8::Unit& u, int wr, int wc, int fr, int fq) const { (*this)(acc, u, wr, wc, fr, fq); }
    __device__ __forceinline__ void operator()(const f32x4 (&acc)[2][2][4][2], const pg8::Unit& u, int wr, int wc, int fr, int fq) const {
        const int b = u.pm >> 3;
        const float* bp = bias + b * NIN + u.pn * 256 + wc * 32 + 8 * fq;
        f32x4 bg[2], bu[2];
#pragma unroll
        for (int n = 0; n < 2; ++n) { bg[n] = *(const f32x4*)(bp + 4 * n); bu[n] = *(const f32x4*)(bp + 128 + 4 * n); }
        const int hid0 = u.pn * 128 + wc * 32 + 8 * fq;
#pragma unroll
        for (int ai = 0; ai < 2; ++ai)
#pragma unroll
            for (int m = 0; m < 4; ++m) {
                const int row = u.pm * 256 + ai * 128 + wr * 64 + m * 16 + fr;
                const float rs = rsqrtf(rowss[row] * (1.f / 1024.f) + EPS);
                v4u w;
#pragma unroll
                for (int n = 0; n < 2; ++n) {
                    const f32x4 g = acc[ai][0][m][n] * rs + bg[n], uu = acc[ai][1][m][n] * rs + bu[n];
                    const float a0 = silu_f(g[0]) * uu[0], a1 = silu_f(g[1]) * uu[1], a2 = silu_f(g[2]) * uu[2], a3 = silu_f(g[3]) * uu[3];
                    if (n == 0) { w.x = pg8::cvt_pk_bf16(a0, a1); w.y = pg8::cvt_pk_bf16(a2, a3); } else { w.z = pg8::cvt_pk_bf16(a0, a1); w.w = pg8::cvt_pk_bf16(a2, a3); }
                }
                *(v4u*)(O + (size_t)row * FF + hid0) = w;
            }
    }
};
struct EpiProj {
    static constexpr bool PERM = true, AFTER_DRAIN = false, TWICE = false;
    bf16* O; const float* rowss; const float* bias; bf16* halo;
    __device__ __forceinline__ void operator()(const f32x4 (&acc)[2][2][4][2], const pg8::Unit& u, int wr, int wc, int fr, int fq) const {
        const int b = u.pm >> 3; const int col0 = u.pn * 256 + wc * 32 + 8 * fq;
        const float* bp = bias + b * NAB + col0;
        f32x4 bv[2][2];
#pragma unroll
        for (int bj = 0; bj < 2; ++bj)
#pragma unroll
            for (int n = 0; n < 2; ++n) bv[bj][n] = *(const f32x4*)(bp + 128 * bj + 4 * n);
        const bool act = u.pn < 4;
#pragma unroll
        for (int ai = 0; ai < 2; ++ai)
#pragma unroll
            for (int m = 0; m < 4; ++m) {
                const int row = u.pm * 256 + ai * 128 + wr * 64 + m * 16 + fr;
                const float rs = rsqrtf(rowss[row] * (1.f / 1024.f) + EPS);
#pragma unroll
                for (int bj = 0; bj < 2; ++bj) {
                    f32x4 v0 = acc[ai][bj][m][0] * rs + bv[bj][0], v1 = acc[ai][bj][m][1] * rs + bv[bj][1];
                    if (act) {
#pragma unroll
                        for (int j = 0; j < 4; ++j) { v0[j] = gelu_tanh_f(v0[j]); v1[j] = gelu_tanh_f(v1[j]); } }
                    v4u w; w.x = pg8::cvt_pk_bf16(v0[0], v0[1]); w.y = pg8::cvt_pk_bf16(v0[2], v0[3]); w.z = pg8::cvt_pk_bf16(v1[0], v1[1]); w.w = pg8::cvt_pk_bf16(v1[2], v1[3]);
                    *(v4u*)(O + (size_t)row * NAB + col0 + 128 * bj) = w;
                    if (ai == 1 && m == 3) { if (wr == 1 && fr >= 14 && u.pn >= 6) *(v4u*)(halo + (size_t)(u.pm * 2 + (fr - 14)) * 1024 + (col0 + 128 * bj - 1536)) = w; }
                }
            }
    }
};
struct EpiResid {
    static constexpr bool PERM = true, AFTER_DRAIN = false, TWICE = PROBE_RESID2;
    const float* xin; float* xout; const float* gate; float* rowss_next; const float* gk_next; bf16* xb;
    __device__ __forceinline__ void operator()(const f32x4 (&acc)[2][2][4][2], const pg8::Unit& u, int wr, int wc, int fr, int fq) const { run(acc, u, wr, wc, fr, fq, xin, 1.f); }
    __device__ __forceinline__ void again(const f32x4 (&acc)[2][2][4][2], const pg8::Unit& u, int wr, int wc, int fr, int fq) const { run(acc, u, wr, wc, fr, fq, xout, 0.f); }
    __device__ __forceinline__ void run(const f32x4 (&acc)[2][2][4][2], const pg8::Unit& u, int wr, int wc, int fr, int fq, const float* xin, const float live) const {
        const int b = u.pm >> 3; const int col0 = u.pn * 256 + wc * 32 + 8 * fq;
        f32x4 gt[2][2], gk[2][2];
#pragma unroll
        for (int bj = 0; bj < 2; ++bj)
#pragma unroll
            for (int n = 0; n < 2; ++n) {
                gt[bj][n] = *(const f32x4*)(gate + b * 1024 + col0 + 128 * bj + 4 * n) * live;
                gk[bj][n] = gk_next ? *(const f32x4*)(gk_next + b * 1024 + col0 + 128 * bj + 4 * n) : (f32x4){0.f, 0.f, 0.f, 0.f};
            }
#pragma unroll
        for (int ai = 0; ai < 2; ++ai)
#pragma unroll
            for (int m = 0; m < 4; ++m) {
                const int row = u.pm * 256 + ai * 128 + wr * 64 + m * 16 + fr;
                float ss = 0.f;
#pragma unroll
                for (int bj = 0; bj < 2; ++bj) {
                    const size_t off = (size_t)row * D + col0 + 128 * bj;
                    f32x4 x0 = *(const f32x4*)(xin + off), x1 = *(const f32x4*)(xin + off + 4);
                    x0 += gt[bj][0] * acc[ai][bj][m][0]; x1 += gt[bj][1] * acc[ai][bj][m][1];
                    *(f32x4*)(xout + off) = x0; *(f32x4*)(xout + off + 4) = x1;
                    ss += (x0[0] * x0[0] + x0[1] * x0[1]) + (x0[2] * x0[2] + x0[3] * x0[3]) + (x1[0] * x1[0] + x1[1] * x1[1]) + (x1[2] * x1[2] + x1[3] * x1[3]);
                    if (gk_next) { const f32x4 y0 = x0 * gk[bj][0], y1 = x1 * gk[bj][1];
                        v4u w; w.x = pg8::cvt_pk_bf16(y0[0], y0[1]); w.y = pg8::cvt_pk_bf16(y0[2], y0[3]); w.z = pg8::cvt_pk_bf16(y1[0], y1[1]); w.w = pg8::cvt_pk_bf16(y1[2], y1[3]);
                        *(v4u*)(xb + off) = w; }
                }
                ss += __shfl_xor(ss, 16); ss += __shfl_xor(ss, 32);
                if (fq == 0) (void)__hip_atomic_fetch_add(rowss_next + row, ss * live, __ATOMIC_RELAXED, __HIP_MEMORY_SCOPE_AGENT);
                asm volatile("" ::: "memory");
            }
    }
};

__device__ __forceinline__ void transpose_item(const float* W, int K, int N, bf16* WT, int mode, LAS float* scr, int item, int lane) {
    const int nblk = N / 32, kb = item / nblk, nb = item % nblk, k0 = 64 * kb, n0 = 32 * nb;
    int drow0 = n0;
    if (mode == 1) { const int j = n0 < FF ? n0 : n0 - FF; drow0 = (j >> 7) * 256 + (j & 127) + (n0 < FF ? 0 : 128); }
#pragma unroll 8
    for (int i = 0; i < 32; ++i) { const int kk = 2 * i + (lane >> 5); scr[kk * 33 + (lane & 31)] = W[(size_t)(k0 + kk) * N + n0 + (lane & 31)]; }
    LDS_WAIT(); asm volatile("" ::: "memory");
    const int c = lane & 7;
#pragma unroll
    for (int j = 0; j < 4; ++j) { const int n = (lane >> 3) + 8 * j; const LAS float* s = scr + (8 * c) * 33 + n;
        v4u o; o.x = pk2(s[0 * 33], s[1 * 33]); o.y = pk2(s[2 * 33], s[3 * 33]); o.z = pk2(s[4 * 33], s[5 * 33]); o.w = pk2(s[6 * 33], s[7 * 33]);
        *(v4u*)(WT + (size_t)(drow0 + n) * K + k0 + 8 * c) = o; }
    LDS_WAIT(); asm volatile("" ::: "memory");
}
__device__ __forceinline__ void mod_task(const float* c, const float* w_mod, const float* b_mod, float* MOD, LAS float* fl, int task, int tid, int wave, int lane) {
    const int l = task / 72, cgp = task % 72;
    for (int i = tid; i < 8192; i += 512) { const float v = c[i]; fl[i] = v / (1.f + __expf(-v)); }
    __syncthreads();
    const int col = cgp * 128 + lane * 2;
    const float* wp = w_mod + (size_t)l * D * MODW + (size_t)(wave * 128) * MODW + col;
    float acc[8][2];
#pragma unroll
    for (int b = 0; b < 8; ++b) { acc[b][0] = 0.f; acc[b][1] = 0.f; }
#pragma unroll 16
    for (int k = 0; k < 128; ++k) {
        const float2 w = *(const float2*)(wp + (size_t)k * MODW);
#pragma unroll
        for (int b = 0; b < 8; ++b) { const float cv = fl[b * 1024 + wave * 128 + k]; acc[b][0] += cv * w.x; acc[b][1] += cv * w.y; }
    }
#pragma unroll
    for (int b = 0; b < 8; ++b) { fl[8192 + (wave * 8 + b) * 128 + lane * 2] = acc[b][0]; fl[8192 + (wave * 8 + b) * 128 + lane * 2 + 1] = acc[b][1]; }
    __syncthreads();
    for (int o = tid; o < 1024; o += 512) { const int b = o >> 7, cc = o & 127; float s = 0.f;
#pragma unroll
        for (int w = 0; w < 8; ++w) s += fl[8192 + (w * 8 + b) * 128 + cc];
        MOD[(size_t)(l * 8 + b) * MODW + cgp * 128 + cc] = s + b_mod[l * MODW + cgp * 128 + cc]; }
    __syncthreads();
}
__device__ __forceinline__ bf16x8 pack8(const float (&v)[8]) {
    v4u o; o.x = pk2(v[0], v[1]); o.y = pk2(v[2], v[3]); o.z = pk2(v[4], v[5]); o.w = pk2(v[6], v[7]);
    return __builtin_bit_cast(bf16x8, o);
}

__device__ __forceinline__ void mid_phase(const bf16* PROJ, bf16* YMIX, const bf16* WST, const float* norm_v, const float* b_s, const float* conv_w, const bf16* HALOP,
                                          LAS unsigned char* lds, int pm, int g, int wave, int lane_in) {
    LAS bf16* vT = (LAS bf16*)lds; constexpr int VS = 136;
#pragma clang loop unroll(disable)
    for (int q = 0; q < 2; ++q) {
        int lane = lane_in; asm volatile("" : "+v"(lane));
        const int fr = lane & 15, fq = lane >> 4;
        const int cidx = 2 * pm + (g >> 1), h = 2 * (g & 1) + q, tok0 = cidx * 128;
        const int hl = lane - 16 * h; const bool mine = (hl >= 0 && hl < 16);
        float nv[8];
#pragma unroll
        for (int j = 0; j < 8; ++j) nv[j] = mine ? norm_v[128 * h + 8 * hl + j] : 0.f;
#pragma unroll 4
        for (int r = 0; r < 16; ++r) {
            const int s = 16 * wave + r;
            const v4u raw = *(const v4u*)(PROJ + (size_t)(tok0 + s) * NAB + 512 + 8 * lane);
            float f[8]; f[0] = bflo(raw.x); f[1] = bfhi(raw.x); f[2] = bflo(raw.y); f[3] = bfhi(raw.y); f[4] = bflo(raw.z); f[5] = bfhi(raw.z); f[6] = bflo(raw.w); f[7] = bfhi(raw.w);
            float sm = ((f[0] + f[1]) + (f[2] + f[3])) + ((f[4] + f[5]) + (f[6] + f[7]));
            const float mean = wave_sum(sm) * (1.f / 512.f);
            float q = 0.f;
#pragma unroll
            for (int j = 0; j < 8; ++j) { f[j] -= mean; q += f[j] * f[j]; }
            const float rs = rsqrtf(wave_sum(q) * (1.f / 512.f) + EPS);
            if (mine) {
#pragma unroll
                for (int j = 0; j < 8; ++j) vT[(8 * hl + j) * VS + s] = (bf16)f2bf(f[j] * rs * nv[j]);
            }
        }
        __syncthreads();
        f32x4 acc[8];
#pragma unroll
        for (int d = 0; d < 8; ++d) acc[d] = (f32x4){0.f, 0.f, 0.f, 0.f};
        const int t0 = 16 * wave, kkmax = (t0 + 15) >> 5;
        for (int kk = 0; kk <= kkmax; ++kk) {
            const bf16x8 wf = *(const bf16x8*)(WST + (size_t)(h * 128 + t0 + fr) * 128 + 32 * kk + 8 * fq);
#pragma unroll
            for (int d = 0; d < 8; ++d) { const bf16x8 vf = *(const LAS bf16x8*)(vT + (16 * d + fr) * VS + 32 * kk + 8 * fq); acc[d] = mfma16(vf, wf, acc[d]); }
        }
        {
            const int t = tok0 + t0 + fr; const float zb = b_s[h * 128 + t0 + fr];
#pragma unroll
            for (int d = 0; d < 8; ++d) {
                const int col = 128 * h + 16 * d + 4 * fq;
                const v2u gu = *(const v2u*)(PROJ + (size_t)t * NAB + col);
                const float y0 = bflo(gu.x) * (acc[d][0] + zb), y1 = bfhi(gu.x) * (acc[d][1] + zb), y2 = bflo(gu.y) * (acc[d][2] + zb), y3 = bfhi(gu.y) * (acc[d][3] + zb);
                v2u w; w.x = pk2(y0, y1); w.y = pk2(y2, y3);
                *(v2u*)(YMIX + (size_t)t * D + col) = w;
            }
        }
        {
            const int tf = tok0 + 32 * h + 4 * wave; const bool halo = (tf & 2047) != 0; const int c = 8 * lane;
            float w0[8], w1[8], w2[8], pm2[8], pm1[8];
#pragma unroll
            for (int j = 0; j < 8; ++j) { w0[j] = conv_w[c + j]; w1[j] = conv_w[512 + c + j]; w2[j] = conv_w[1024 + c + j]; pm2[j] = 0.f; pm1[j] = 0.f; }
            if (halo) {
                const bool nb = (tf & 255) == 0;
                const bf16* p2 = nb ? HALOP + (size_t)((pm - 1) * 2 + 0) * 1024 + c - 1536 : PROJ + (size_t)(tf - 2) * NAB + c;
                const bf16* p1 = nb ? HALOP + (size_t)((pm - 1) * 2 + 1) * 1024 + c - 1536 : PROJ + (size_t)(tf - 1) * NAB + c;
                const v4u a2 = *(const v4u*)(p2 + 1536), b2 = *(const v4u*)(p2 + 2048), a1 = *(const v4u*)(p1 + 1536), b1 = *(const v4u*)(p1 + 2048);
                pm2[0] = bflo(a2.x) * bflo(b2.x); pm2[1] = bfhi(a2.x) * bfhi(b2.x); pm2[2] = bflo(a2.y) * bflo(b2.y); pm2[3] = bfhi(a2.y) * bfhi(b2.y);
                pm2[4] = bflo(a2.z) * bflo(b2.z); pm2[5] = bfhi(a2.z) * bfhi(b2.z); pm2[6] = bflo(a2.w) * bflo(b2.w); pm2[7] = bfhi(a2.w) * bfhi(b2.w);
                pm1[0] = bflo(a1.x) * bflo(b1.x); pm1[1] = bfhi(a1.x) * bfhi(b1.x); pm1[2] = bflo(a1.y) * bflo(b1.y); pm1[3] = bfhi(a1.y) * bfhi(b1.y);
                pm1[4] = bflo(a1.z) * bflo(b1.z); pm1[5] = bfhi(a1.z) * bfhi(b1.z); pm1[6] = bflo(a1.w) * bflo(b1.w); pm1[7] = bfhi(a1.w) * bfhi(b1.w);
            }
#pragma unroll
            for (int r = 0; r < 4; ++r) {
                const bf16* pr = PROJ + (size_t)(tf + r) * NAB + c;
                const v4u g = *(const v4u*)(pr + 1024), a = *(const v4u*)(pr + 1536), x = *(const v4u*)(pr + 2048);
                float cur[8], bgv[8], y[8];
                cur[0] = bflo(a.x) * bflo(x.x); cur[1] = bfhi(a.x) * bfhi(x.x); cur[2] = bflo(a.y) * bflo(x.y); cur[3] = bfhi(a.y) * bfhi(x.y);
                cur[4] = bflo(a.z) * bflo(x.z); cur[5] = bfhi(a.z) * bfhi(x.z); cur[6] = bflo(a.w) * bflo(x.w); cur[7] = bfhi(a.w) * bfhi(x.w);
                bgv[0] = bflo(g.x); bgv[1] = bfhi(g.x); bgv[2] = bflo(g.y); bgv[3] = bfhi(g.y); bgv[4] = bflo(g.z); bgv[5] = bfhi(g.z); bgv[6] = bflo(g.w); bgv[7] = bfhi(g.w);
#pragma unroll
                for (int j = 0; j < 8; ++j) { y[j] = bgv[j] * (w0[j] * pm2[j] + w1[j] * pm1[j] + w2[j] * cur[j]); pm2[j] = pm1[j]; pm1[j] = cur[j]; }
                v4u o; o.x = pk2(y[0], y[1]); o.y = pk2(y[2], y[3]); o.z = pk2(y[4], y[5]); o.w = pk2(y[6], y[7]);
                *(v4u*)(YMIX + (size_t)(tf + r) * D + 512 + c) = o;
            }
        }
        __syncthreads();
    }
}

constexpr int PS = 264;
template <int W> __device__ __forceinline__ void pool_build(const float* X2, const float* rowss, const float* gkp, const float* shp, LAS bf16* P, int tile0, int g, int wave, int lane) {
    const int c = 256 * g + 4 * lane, trow0 = tile0 + 16 * wave, tpos0 = trow0 & 2047;
    const f32x4 gk = *(const f32x4*)(gkp + c), sh = *(const f32x4*)(shp + c);
    f32x4 ring[W];
#pragma unroll
    for (int r = -(W - 1); r < 16; ++r) {
        const int t = trow0 + r; const bool valid = (tpos0 + r) >= 0;
        f32x4 hv = (f32x4){0.f, 0.f, 0.f, 0.f};
        if (valid) { const float rs = rsqrtf(rowss[t] * (1.f / 1024.f) + EPS); const f32x4 xv = *(const f32x4*)(X2 + (size_t)t * D + c); hv = xv * rs * gk + sh; }
        ring[(r + 16) % W] = hv;
        if (r >= 0) {
            f32x4 S = ring[0];
#pragma unroll
            for (int q = 1; q < W; ++q) S += ring[q];
            const float inv = (tpos0 == 0 && (r + 1) < W) ? (1.f / (float)(r + 1)) : (1.f / (float)W);
            const f32x4 p = S * inv - hv;
            v2u o; o.x = pk2(p[0], p[1]); o.y = pk2(p[2], p[3]);
            *(LAS v2u*)(P + (16 * wave + r) * PS + 4 * lane) = o;
        }
        if (((r + 16) & 3) == 3) asm volatile("" ::: "memory");
    }
}
__device__ __forceinline__ void pool_phase(const float* X2, float* XO, const float* rowss4, float* rowss5, const float* gk4, const float* shift4, const float* gate4, const float* gk5,
                                           const bf16* WGT, bf16* XB, LAS unsigned char* lds, int pm, int gi, int wave, int lane_in) {
    LAS bf16* P = (LAS bf16*)lds;
#pragma clang loop unroll(disable)
    for (int q = 0; q < 2; ++q) {
        int lane = lane_in; asm volatile("" : "+v"(lane));
        const int fr = lane & 15, fq = lane >> 4;
        const int tile = 2 * pm + (gi >> 1), g = 2 * (gi & 1) + q, tile0 = tile * 128, b = tile0 >> 11;
        const float* gkp = gk4 + b * 1024; const float* shp = shift4 + (size_t)b * MODW;
        if (g == 0) pool_build<2>(X2, rowss4, gkp, shp, P, tile0, g, wave, lane);
        else if (g == 1) pool_build<4>(X2, rowss4, gkp, shp, P, tile0, g, wave, lane);
        else if (g == 2) pool_build<8>(X2, rowss4, gkp, shp, P, tile0, g, wave, lane);
        else pool_build<16>(X2, rowss4, gkp, shp, P, tile0, g, wave, lane);
        __syncthreads();
        f32x4 acc[8][2];
#pragma unroll
        for (int tb = 0; tb < 8; ++tb) { acc[tb][0] = (f32x4){0.f, 0.f, 0.f, 0.f}; acc[tb][1] = (f32x4){0.f, 0.f, 0.f, 0.f}; }
        const bf16* wbase = WGT + (size_t)(g * 256 + 32 * wave + fr) * 256 + 8 * fq;
#pragma unroll
        for (int kk = 0; kk < 8; ++kk) {
            const bf16x8 wf0 = *(const bf16x8*)(wbase + 32 * kk), wf1 = *(const bf16x8*)(wbase + 16 * 256 + 32 * kk);
#pragma unroll
            for (int tb = 0; tb < 8; ++tb) {
                const bf16x8 pf = *(const LAS bf16x8*)(P + (16 * tb + fr) * PS + 32 * kk + 8 * fq);
                acc[tb][0] = mfma16(wf0, pf, acc[tb][0]); acc[tb][1] = mfma16(wf1, pf, acc[tb][1]);
            }
        }
        const int colb = 256 * g + 32 * wave + 4 * fq;
        f32x4 gt[2], gk[2];
#pragma unroll
        for (int nb = 0; nb < 2; ++nb) { gt[nb] = *(const f32x4*)(gate4 + b * 1024 + colb + 16 * nb); gk[nb] = *(const f32x4*)(gk5 + b * 1024 + colb + 16 * nb); }
#pragma unroll
        for (int tb = 0; tb < 8; ++tb) {
            const int t = tile0 + 16 * tb + fr; float ss = 0.f;
#pragma unroll
            for (int nb = 0; nb < 2; ++nb) {
                const size_t off = (size_t)t * D + colb + 16 * nb;
                f32x4 xv = *(const f32x4*)(X2 + off); xv += gt[nb] * acc[tb][nb];
                *(f32x4*)(XO + off) = xv;
                ss += (xv[0] * xv[0] + xv[1] * xv[1]) + (xv[2] * xv[2] + xv[3] * xv[3]);
                const f32x4 y = xv * gk[nb]; v2u o; o.x = pg8::cvt_pk_bf16(y[0], y[1]); o.y = pg8::cvt_pk_bf16(y[2], y[3]);
                *(v2u*)(XB + off) = o;
            }
            ss += __shfl_xor(ss, 16); ss += __shfl_xor(ss, 32);
            if (fq == 0) (void)__hip_atomic_fetch_add(rowss5 + t, ss, __ATOMIC_RELAXED, __HIP_MEMORY_SCOPE_AGENT);
        }
        __syncthreads();
    }
}

#define GB_SPIN_CAP (1u << 22)
__device__ __forceinline__ void group_wait_t0(unsigned* cnt, unsigned want) {
    unsigned sp = 0u;
    while (__hip_atomic_load(cnt, __ATOMIC_RELAXED, __HIP_MEMORY_SCOPE_AGENT) < want) { __builtin_amdgcn_s_sleep(1); if (++sp > GB_SPIN_CAP) break; }
    __builtin_amdgcn_fence(__ATOMIC_ACQUIRE, "agent");
    asm volatile("s_waitcnt vmcnt(0)" ::: "memory");
}
__device__ __forceinline__ void group_barrier(unsigned* cnt, unsigned& k) {
    asm volatile("s_waitcnt vmcnt(0)" ::: "memory");
    __syncthreads();
    if (threadIdx.x == 0) {
        __builtin_amdgcn_fence(__ATOMIC_RELEASE, "agent");
        asm volatile("s_waitcnt vmcnt(0)" ::: "memory");
        (void)__hip_atomic_fetch_add(cnt, 1u, __ATOMIC_RELAXED, __HIP_MEMORY_SCOPE_AGENT);
        group_wait_t0(cnt, 4u * (k + 1u));
    }
    ++k;
    __syncthreads();
}
__device__ __forceinline__ void neighbour_wait(unsigned* cnt, unsigned want) {
    if (threadIdx.x == 0) group_wait_t0(cnt, want);
    __syncthreads();
}

__device__ __forceinline__ int lane_of(int& t) { asm volatile("" : "+v"(t)); return t & 63; }
struct Args { const float* in[16]; float* out; unsigned char* ws; int never; int pad; };
typedef const __attribute__((address_space(4))) Args* KArgs;
__device__ __forceinline__ KArgs kargs() { KArgs p = (KArgs)__builtin_amdgcn_kernarg_segment_ptr(); asm volatile("" : "+s"(p)); return p; }

__global__ void __launch_bounds__(512, 2) fwd_mega(Args a) {
    extern __shared__ __attribute__((aligned(16))) unsigned char lds_raw[];
    LAS unsigned char* lds = (LAS unsigned char*)lds_raw;
    int tid_l = threadIdx.x; asm volatile("" : "+v"(tid_l));
#define tid ((int)tid_l)
#define lane (lane_of(tid_l))
    const int wave = __builtin_amdgcn_readfirstlane(tid_l >> 6);
    const int G = gridDim.x, bx = blockIdx.x;
    const int gw = bx * 8 + wave, NGW = G * 8;
    for (int u = tid; u < (LDS_BYTES - LDSCTL_OFF) / 4; u += 512) ((LAS unsigned*)(lds + LDSCTL_OFF))[u] = 0u;
    __syncthreads();
    XcdBarrier bar = xcd_barrier_post((unsigned*)(kargs()->ws + WS_CTL) + CW_BAR, (volatile LAS unsigned*)(lds + MISC_OFF) + 8);
    if (kargs()->never) cg::this_grid().sync();
#define GRID_BAR() xcd_barrier(bar)
    const int pm_g = 8 * (bx & 7) + ((bx >> 3) & 7), gi = bx >> 6;
    unsigned gk_n = 0u;
#define GCNT(p) ((unsigned*)(kargs()->ws + WS_CTL) + CW_GRP + 64 * (p))
#define GROUP_BAR() group_barrier(GCNT(pm_g), gk_n)
#define HALOP ((bf16*)WSP(WS_HALOP))
#define IN_(i) (kargs()->in[i])
#define WSP(off) (kargs()->ws + (off))
#define x_in IN_(0)
#define c_in IN_(1)
#define norm_g IN_(2)
#define w_mod IN_(3)
#define b_mod IN_(4)
#define w_ffn_in IN_(5)
#define w_ffn_out IN_(6)
#define ab_w_in IN_(7)
#define ab_norm_v IN_(8)
#define ab_w_s IN_(9)
#define ab_b_s IN_(10)
#define ab_conv_w IN_(11)
#define ab_w_out IN_(12)
#define pool_w_grp IN_(13)
#define pool_scale IN_(14)
#define final_g IN_(15)
#define out (kargs()->out)
#define MOD ((float*)WSP(WS_MOD))
#define GK ((float*)WSP(WS_GK))
#define GATE ((float*)WSP(WS_GATE))
#define BIAS ((float*)WSP(WS_BIAS))
#define ROWSS ((float*)WSP(WS_ROWSS))
#define WST ((bf16*)WSP(WS_WS))
#define WGT ((bf16*)WSP(WS_WGT))
#define WIN ((bf16*)WSP(WS_WIN))
#define WOUT ((bf16*)WSP(WS_WOUT))
#define ABIN ((bf16*)WSP(WS_ABIN))
#define ABOUT ((bf16*)WSP(WS_ABOUT))
#define XB ((bf16*)WSP(WS_XB))
#define YMIX ((bf16*)WSP(WS_YMIX))
#define ACT ((bf16*)WSP(WS_ACT))
#define X2 ((float*)WSP(WS_X2))

    {
        if (bx < 144) mod_task(c_in, w_mod, b_mod, MOD, (LAS float*)lds, bx, tid, wave, lane);
        LAS float* scr = (LAS float*)(lds + wave * 16384);
        constexpr int I_IN = 16 * 176, I_OUT = 44 * 32, I_ABIN = 16 * 80, I_ABOUT = 16 * 32, I_PG = 4 * 8;
        constexpr int NITEMS = 4 * I_IN + 4 * I_OUT + I_ABIN + I_ABOUT + 4 * I_PG;
        for (int it = gw; it < NITEMS; it += NGW) {
            int r = it;
            if (r < 4 * I_IN) { const int q = r / I_IN; r -= q * I_IN; transpose_item(w_ffn_in + (size_t)q * D * NIN, D, NIN, WIN + (size_t)q * NIN * D, 1, scr, r, lane); continue; } r -= 4 * I_IN;
            if (r < 4 * I_OUT) { const int q = r / I_OUT; r -= q * I_OUT; transpose_item(w_ffn_out + (size_t)q * FF * D, FF, D, WOUT + (size_t)q * D * FF, 0, scr, r, lane); continue; } r -= 4 * I_OUT;
            if (r < I_ABIN) { transpose_item(ab_w_in, D, NAB, ABIN, 0, scr, r, lane); continue; } r -= I_ABIN;
            if (r < I_ABOUT) { transpose_item(ab_w_out, D, D, ABOUT, 0, scr, r, lane); continue; } r -= I_ABOUT;
            { const int q = r / I_PG; r -= q * I_PG; transpose_item(pool_w_grp + (size_t)q * 65536, 256, 256, WGT + (size_t)q * 65536, 0, scr, r, lane); }
        }
        for (int i = bx * 512 + tid; i < 4 * 128 * 128; i += G * 512) { const int s = i & 127, t = (i >> 7) & 127; WST[i] = (s <= t) ? (bf16)f2bf(ab_w_s[i]) : (bf16)0; }
        for (int i = bx * 512 + tid; i < 6 * T; i += G * 512) ROWSS[T + i] = 0.f;
    }
    GRID_BAR();
    {
        for (int idx = bx * 512 + tid; idx < 6 * 8 * 1024; idx += G * 512) {
            const int i = idx >> 13, b = (idx >> 10) & 7, k = idx & 1023, l = i / 3, s = i - 3 * l;
            const float* mb = MOD + (size_t)(l * 8 + b) * MODW + s * 3072;
            GK[idx] = norm_g[i * 1024 + k] * (1.f + mb[1024 + k]);
            float g = mb[2048 + k] * (s == 1 ? 1.f : 0.5f); if (i == 4) g *= pool_scale[k];
            GATE[idx] = g;
        }
        constexpr int BT_IN = NIN / 16, BT_AB = NAB / 16, NBT = 4 * BT_IN + BT_AB;
        const int fr = lane & 15, fq = lane >> 4;
        for (int tk = gw; tk < NBT; tk += NGW) {
            int g, r0, N, i; const bf16* Bt;
            if (tk < 4 * BT_IN) { g = tk / BT_IN; r0 = (tk - g * BT_IN) * 16; Bt = WIN + (size_t)g * NIN * D; N = NIN; i = (g >> 1) * 3 + (g & 1) * 2; }
            else { g = 4; r0 = (tk - 4 * BT_IN) * 16; Bt = ABIN; N = NAB; i = 1; }
            const int l = i / 3, s = i - 3 * l;
            const float* shp = MOD + (size_t)(l * 8 + (fr & 7)) * MODW + s * 3072 + 8 * fq;
            const bf16* ap = Bt + (size_t)(r0 + fr) * D + 8 * fq;
            f32x4 acc = (f32x4){0.f, 0.f, 0.f, 0.f};
#pragma unroll 4
            for (int kk = 0; kk < 32; ++kk) {
                const bf16x8 av = *(const bf16x8*)(ap + 32 * kk);
                const f32x4 s0 = *(const f32x4*)(shp + 32 * kk), s1 = *(const f32x4*)(shp + 32 * kk + 4);
                float hi[8], lo[8];
#pragma unroll
                for (int j = 0; j < 4; ++j) { hi[j] = __uint_as_float(f2bf(s0[j]) << 16); lo[j] = s0[j] - hi[j]; hi[4 + j] = __uint_as_float(f2bf(s1[j]) << 16); lo[4 + j] = s1[j] - hi[4 + j]; }
                acc = mfma16(av, pack8(hi), acc); acc = mfma16(av, pack8(lo), acc);
            }
            if (fr < 8) *(f32x4*)(BIAS + (size_t)g * BIAS_STRIDE_F + (size_t)fr * N + r0 + 4 * fq) = acc;
        }
        for (int m = gw; m < T; m += NGW) {
            const int b = m >> 11; const float* xr = x_in + (size_t)m * D; const float* mb = MOD + (size_t)b * MODW + 1024;
            f32x4 v[4]; float ss = 0.f;
#pragma unroll
            for (int j = 0; j < 4; ++j) { v[j] = *(const f32x4*)(xr + 4 * lane + 256 * j); ss += (v[j][0] * v[j][0] + v[j][1] * v[j][1]) + (v[j][2] * v[j][2] + v[j][3] * v[j][3]); }
            ss = wave_sum(ss); if (lane == 0) ROWSS[m] = ss;
#pragma unroll
            for (int j = 0; j < 4; ++j) { const int c = 4 * lane + 256 * j; const f32x4 g = *(const f32x4*)(norm_g + c), sc = *(const f32x4*)(mb + c); const f32x4 y = v[j] * g * (sc + 1.f);
                v2u o; o.x = pk2(y[0], y[1]); o.y = pk2(y[2], y[3]); *(v2u*)(XB + (size_t)m * D + c) = o; }
        }
    }
    GRID_BAR();
#pragma clang loop unroll(disable)
    for (int f = 0; f < 4; ++f) {
        const int l = f >> 1, i = 3 * l + 2 * (f & 1);
        {
            pg8::Gemm g{XB, WIN + (size_t)f * NIN * D, T, NIN, D}; pg8::StaticOrder S; S.init(T, NIN, G, bx);
            EpiSwiglu E{ACT, ROWSS + (size_t)i * T, BIAS + (size_t)f * BIAS_STRIDE_F};
            pg8::gemm_phase<EpiSwiglu, pg8::StaticOrder, true, true>(lds, g, S, E);
        }
        GROUP_BAR();
        {
            pg8::Gemm g{ACT, WOUT + (size_t)f * D * FF, T, D, FF}; pg8::StaticOrder S; S.init(T, D, G, bx);
            EpiResid E{f == 0 ? x_in : out, f == 2 ? X2 : out, GATE + (size_t)i * 8192, ROWSS + (size_t)(i + 1) * T, f < 2 ? GK + (size_t)(i + 1) * 8192 : nullptr, XB};
            pg8::gemm_phase<EpiResid, pg8::StaticOrder, true, true>(lds, g, S, E);
        }
        GROUP_BAR();
        if (f == 0) {
            {
                pg8::Gemm g{XB, ABIN, T, NAB, D}; pg8::StaticOrder S; S.init(T, NAB, G, bx);
                EpiProj E{ACT, ROWSS + (size_t)1 * T, BIAS + (size_t)4 * BIAS_STRIDE_F, HALOP};
                pg8::gemm_phase<EpiProj, pg8::StaticOrder, true, true>(lds, g, S, E);
            }
            GROUP_BAR();
            if ((pm_g & 7) != 0 && gi == 0) neighbour_wait(GCNT(pm_g - 1), 12u);
            mid_phase(ACT, YMIX, WST, ab_norm_v, ab_b_s, ab_conv_w, HALOP, lds, pm_g, gi, wave, lane);
            GROUP_BAR();
            {
                pg8::Gemm g{YMIX, ABOUT, T, D, D}; pg8::StaticOrder S; S.init(T, D, G, bx);
                EpiResid E{out, out, GATE + (size_t)1 * 8192, ROWSS + (size_t)2 * T, GK + (size_t)2 * 8192, XB};
                pg8::gemm_phase<EpiResid, pg8::StaticOrder, true, true>(lds, g, S, E);
            }
            GROUP_BAR();
        } else if (f == 2) {
            if ((pm_g & 7) != 0 && gi < 2) neighbour_wait(GCNT(pm_g - 1), 36u);
            pool_phase(X2, out, ROWSS + (size_t)4 * T, ROWSS + (size_t)5 * T, GK + (size_t)4 * 8192, MOD + (size_t)8 * MODW + 3072, GATE + (size_t)4 * 8192, GK + (size_t)5 * 8192,
                       WGT, XB, lds, pm_g, gi, wave, lane);
            GROUP_BAR();
        }
    }
    for (int m = 256 * pm_g + 64 * gi + wave; m < 256 * pm_g + 64 * gi + 64; m += 8) {
        const float rs = rsqrtf(ROWSS[(size_t)6 * T + m] * (1.f / 1024.f) + EPS);
#pragma unroll
        for (int j = 0; j < 4; ++j) { const int c = 4 * lane + 256 * j; f32x4 v = *(const f32x4*)(out + (size_t)m * D + c); const f32x4 g = *(const f32x4*)(final_g + c); v = v * rs * g; *(f32x4*)(out + (size_t)m * D + c) = v; }
    }
}

#undef tid
#undef lane
#undef GRID_BAR
#undef GROUP_BAR
#undef GCNT
#undef HALOP
#undef IN_
#undef WSP
#undef x_in
#undef c_in
#undef norm_g
#undef w_mod
#undef b_mod
#undef w_ffn_in
#undef w_ffn_out
#undef ab_w_in
#undef ab_norm_v
#undef ab_w_s
#undef ab_b_s
#undef ab_conv_w
#undef ab_w_out
#undef pool_w_grp
#undef pool_scale
#undef final_g
#undef out
#undef MOD
#undef GK
#undef GATE
#undef BIAS
#undef ROWSS
#undef WST
#undef WGT
#undef WIN
#undef WOUT
#undef ABIN
#undef ABOUT
#undef XB
#undef YMIX
#undef ACT
#undef X2

extern "C" void kernel_launch(void* const* d_in, const int* in_sizes, int n_in, void* d_out, int out_size, void* d_ws, size_t ws_size, hipStream_t stream) {
    static int grid = 0;
    if (grid == 0) {
        if (n_in != 16 || in_sizes[0] != T * D || out_size != T * D || ws_size < WS_END) { fprintf(stderr, "kernel_launch: unexpected shapes (n_in %d, in0 %d, out %d, ws %zu)\n", n_in, n_in > 0 ? in_sizes[0] : -1, out_size, ws_size); grid = -1; return; }
        int dev = 0, cus = 0, per_cu = 0;
        if (hipGetDevice(&dev) != hipSuccess || hipDeviceGetAttribute(&cus, hipDeviceAttributeMultiprocessorCount, dev) != hipSuccess) { grid = -1; return; }
        if (hipFuncSetAttribute((const void*)fwd_mega, hipFuncAttributeMaxDynamicSharedMemorySize, LDS_BYTES) != hipSuccess) { fprintf(stderr, "kernel_launch: hipFuncSetAttribute failed\n"); grid = -1; return; }
        if (hipOccupancyMaxActiveBlocksPerMultiprocessor(&per_cu, (const void*)fwd_mega, 512, LDS_BYTES) != hipSuccess || per_cu < 1) { fprintf(stderr, "kernel_launch: occupancy query says %d blocks per CU\n", per_cu); per_cu = 1; }
        (void)hipGetLastError();
        if (cus < 256) { fprintf(stderr, "kernel_launch: built for a 256-CU device (got %d CUs)\n", cus); grid = -1; return; }
        grid = 256;
    }
    if (grid < 0) return;
    (void)hipMemsetAsync((char*)d_ws + WS_CTL, 0, CTL_ZERO_BYTES, stream);
    Args a{};
    for (int i = 0; i < 16; ++i) a.in[i] = (const float*)d_in[i];
    a.out = (float*)d_out; a.ws = (unsigned char*)d_ws; a.never = 0; a.pad = 0;
    void* args[] = {&a};
    const hipError_t e = hipLaunchCooperativeKernel((const void*)fwd_mega, dim3(grid), dim3(512), args, LDS_BYTES, stream);
    if (e != hipSuccess) fprintf(stderr, "kernel_launch: cooperative launch failed: %s (grid %d)\n", hipGetErrorString(e), grid);
}
```

```cpp
#include <hip/hip_runtime.h>
#include <hip/hip_cooperative_groups.h>
#include <cstdio>
#include <cstdint>
namespace cg = cooperative_groups;
namespace pg8 {
#define PG8_LAS __attribute__((address_space(3)))
typedef unsigned short bf16_t;
typedef short bf16x8 __attribute__((ext_vector_type(8)));
typedef float f32x4 __attribute__((ext_vector_type(4)));
typedef unsigned u32x4 __attribute__((ext_vector_type(4)));
constexpr int BM = 256, BK = 64, HALF = 128, HTB = HALF * BK * 2  , STAGE_BYTES = 8 * HTB, NXCD = 8, WGM = 8;

__host__ __device__ __forceinline__ int lds_byte(int r, int c) { const int st = (r >> 4) * 2 + (c >> 5), rr = r & 15, cc = c & 31, ob = rr * 64 + cc * 2; return st * 1024 + (ob ^ (((ob >> 9) & 1) << 5)); }
__host__ __device__ __forceinline__ void stage_rc(int b, int& R, int& C) { const int st = b / 1024, sb = b % 1024, swz = sb ^ (((sb >> 9) & 1) << 5); R = (st >> 1) * 16 + swz / 64; C = (st & 1) * 32 + (swz % 64) / 2; }
__host__ __device__ __forceinline__ int perm32(int rho) { const int n = rho >> 4, i = rho & 15; return 8 * (i >> 2) + 4 * n + (i & 3); }

struct Unit { int pm, pn; };
struct Gemm { const bf16_t* A; const bf16_t* Bt; int M, N, K; };

struct StaticOrder {
    int nM, nN, nwg, G, c;
    __host__ __device__ void init(int M, int N, int G_, int c_) { nM = M / BM; nN = N / BM; nwg = nM * nN; G = G_; c = c_; }
    __host__ __device__ bool next(int i, Unit& u) const {
        const long L = (long)i * G + c; if (L >= nwg) return false;
        int wgid = (int)L; { const int q = nwg / NXCD, r = nwg % NXCD, xcd = wgid % NXCD, off = wgid / NXCD; wgid = (xcd < r ? xcd * (q + 1) : r * (q + 1) + (xcd - r) * q) + off; }
        const int nig = WGM * nN, gid = wgid / nig, fm = gid * WGM, gsz = (nM - fm) < WGM ? (nM - fm) : WGM;
        u.pm = fm + ((wgid % nig) % gsz); u.pn = (wgid % nig) / gsz; return true;
    }
    __device__ __forceinline__ void a_ready(const Unit&) const {}
    __device__ __forceinline__ void done(const Unit&) const {}
};

__device__ __forceinline__ unsigned cvt_pk_bf16(float lo, float hi) { unsigned r; asm volatile("v_cvt_pk_bf16_f32 %0, %1, %2" : "=v"(r) : "v"(lo), "v"(hi)); return r; }
template <class Epi, class Sched, bool ALIGN_EPI = false, bool SP2 = false>
__device__ __forceinline__ void gemm_phase(PG8_LAS unsigned char* lds, const Gemm g, const Sched& S, const Epi& E, const int wave_id) {
    int lz = 0; asm volatile("" : "+v"(lz));
    const int lane_m = (int)__builtin_amdgcn_mbcnt_hi(~0u, __builtin_amdgcn_mbcnt_lo(~0u, (unsigned)lz));
    int wave_l = wave_id; asm volatile("" : "+s"(wave_l));
    const int tid = wave_l * 64 + lane_m, wid = wave_l, lane = lane_m, wr = wid >> 2, wc = wid & 3, fr = lane & 15, fq = lane >> 4;
    const int K = g.K, nt = K / BK;
    unsigned voffA[2], voffB[2];
#pragma unroll
    for (int i = 0; i < 2; ++i) { int R, C; stage_rc(tid * 16 + i * 8192, R, C); const int Rb = Epi::PERM ? ((R & ~31) + perm32(R & 31)) : R;
        voffA[i] = (unsigned)(R * K + C) * 2u; voffB[i] = (unsigned)(Rb * K + C) * 2u; }
    const size_t kstep = (size_t)(BK * 2);
    const size_t hstep = (size_t)HALF * K * 2;
    const size_t tstep = 2 * hstep;
    const unsigned ldsw = (unsigned)wid * 1024u;
    const int aoff = lds_byte(wr * 64 + fr, fq * 8), boff = lds_byte(wc * 32 + fr, fq * 8);
#define PG8_SA(b, h) (((b) * 2 + (h)) * HTB)
#define PG8_SB(b, h) ((4 + (b) * 2 + (h)) * HTB)
#define PG8_STAGE(bufoff, gbase, voff) do { _Pragma("unroll") for (int _i = 0; _i < 2; ++_i) \
        __builtin_amdgcn_global_load_lds((const unsigned*)((const char*)(gbase) + (voff)[_i]), (PG8_LAS unsigned*)(lds + (bufoff) + ldsw + _i * 8192), 16, 0, 0); } while (0)
#define PG8_LDA(dst, b, h) do { _Pragma("unroll") for (int m = 0; m < 4; ++m) _Pragma("unroll") for (int k = 0; k < 2; ++k) dst[m][k] = *(const PG8_LAS bf16x8*)(lds + PG8_SA(b, h) + aoff + m * 2048 + k * 1024); } while (0)
#define PG8_LDB(dst, b, h) do { _Pragma("unroll") for (int n = 0; n < 2; ++n) _Pragma("unroll") for (int k = 0; k < 2; ++k) dst[n][k] = *(const PG8_LAS bf16x8*)(lds + PG8_SB(b, h) + boff + n * 2048 + k * 1024); } while (0)
#define PG8_MMA(ai, bj, At, Bt) do { __builtin_amdgcn_s_setprio(1); _Pragma("unroll") for (int m = 0; m < 4; ++m) _Pragma("unroll") for (int n = 0; n < 2; ++n) _Pragma("unroll") for (int k = 0; k < 2; ++k) \
        acc[ai][bj][m][n] = __builtin_amdgcn_mfma_f32_16x16x32_bf16(Bt[n][k], At[m][k], acc[ai][bj][m][n], 0, 0, 0); __builtin_amdgcn_s_setprio(0); } while (0)
#define PG8_WAIT_V(n) asm volatile("s_waitcnt vmcnt(" #n ")" ::: "memory")
#define PG8_WAIT_V_RELAX(flag, nrel) asm volatile("s_cmp_lg_u32 %0, 0\n\ts_cbranch_scc1 .Lpg8rx%=\n\ts_waitcnt vmcnt(8)\n\ts_branch .Lpg8ry%=\n.Lpg8rx%=:\n\ts_waitcnt vmcnt(" #nrel ")\n.Lpg8ry%=:" :: "s"(flag) : "memory", "scc")
#define PG8_WAIT_L(n) asm volatile("s_waitcnt lgkmcnt(" #n ")" ::: "memory")
#define PG8_BAR __builtin_amdgcn_s_barrier()
#define PG8_SCHED __builtin_amdgcn_sched_barrier(0)
    Unit cur, nxt; int ui = 0;
    if (!S.next(0, cur)) return;
    f32x4 acc[2][2][4][2];
#pragma unroll
    for (int a = 0; a < 2; ++a)
#pragma unroll
        for (int b = 0; b < 2; ++b)
#pragma unroll
            for (int m = 0; m < 4; ++m)
#pragma unroll
                for (int n = 0; n < 2; ++n) acc[a][b][m][n] = (f32x4){0.f, 0.f, 0.f, 0.f};
    bf16x8 At[4][2], B0[2][2], B1[2][2];
    const char* cA = (const char*)g.A + (size_t)cur.pm * tstep; const char* cB = (const char*)g.Bt + (size_t)cur.pn * tstep;
    S.a_ready(cur);
    if constexpr (SP2) {
        PG8_STAGE(PG8_SB(0, 0), cB, voffB); PG8_STAGE(PG8_SB(0, 1), cB + hstep, voffB); PG8_STAGE(PG8_SA(0, 0), cA, voffA); PG8_STAGE(PG8_SA(0, 1), cA + hstep, voffA);
        if (wr == 1) PG8_BAR;
        PG8_WAIT_V(2); PG8_BAR;
        PG8_STAGE(PG8_SB(1, 0), cB + kstep, voffB); PG8_STAGE(PG8_SA(1, 0), cA + kstep, voffA); PG8_STAGE(PG8_SB(1, 1), cB + hstep + kstep, voffB);
        PG8_WAIT_V(6); PG8_BAR;
    } else {
        PG8_STAGE(PG8_SB(0, 0), cB, voffB); PG8_STAGE(PG8_SA(0, 0), cA, voffA); PG8_STAGE(PG8_SB(0, 1), cB + hstep, voffB); PG8_STAGE(PG8_SA(0, 1), cA + hstep, voffA);
        if (wr == 1) PG8_BAR;
        PG8_WAIT_V(4); PG8_BAR;
        PG8_STAGE(PG8_SB(1, 0), cB + kstep, voffB); PG8_STAGE(PG8_SA(1, 0), cA + kstep, voffA); PG8_STAGE(PG8_SB(1, 1), cB + hstep + kstep, voffB);
        PG8_WAIT_V(6); PG8_BAR;
    }
    for (;;) {
        const bool has_next = S.next(ui + 1, nxt);
        const char* nA = has_next ? (const char*)g.A + (size_t)nxt.pm * tstep : cA; const char* nB = has_next ? (const char*)g.Bt + (size_t)nxt.pn * tstep : cB;
        for (int t = 0; t < nt; t += 2) {
            const bool last = (t == nt - 2);
            const char* a1 = cA + (size_t)(t + 1) * kstep;
            const char* a2 = last ? nA : cA + (size_t)(t + 2) * kstep; const char* b2 = last ? nB : cB + (size_t)(t + 2) * kstep;
            const char* a3 = a2 + kstep; const char* b3 = b2 + kstep;
            if (last && has_next) S.a_ready(nxt);
            if constexpr (SP2) {
            PG8_LDB(B0, 0, 0); PG8_LDB(B1, 0, 1); PG8_SCHED; PG8_LDA(At, 0, 0); PG8_STAGE(PG8_SA(1, 1), a1 + hstep, voffA);
            PG8_WAIT_V(8); PG8_WAIT_L(0); PG8_BAR; PG8_MMA(0, 0, At, B0); PG8_MMA(0, 1, At, B1); PG8_BAR; PG8_SCHED;
            PG8_LDA(At, 0, 1); PG8_STAGE(PG8_SB(0, 0), b2, voffB); PG8_STAGE(PG8_SB(0, 1), b2 + hstep, voffB); PG8_STAGE(PG8_SA(0, 0), a2, voffA);
            PG8_WAIT_V(8); PG8_WAIT_L(0); PG8_BAR; PG8_MMA(1, 0, At, B0); PG8_MMA(1, 1, At, B1); PG8_BAR; PG8_SCHED;
            PG8_LDB(B0, 1, 0); PG8_LDB(B1, 1, 1); PG8_SCHED; PG8_LDA(At, 1, 0); PG8_STAGE(PG8_SA(0, 1), a2 + hstep, voffA);
            PG8_WAIT_V(8); PG8_WAIT_L(0); PG8_BAR; PG8_MMA(0, 0, At, B0); PG8_MMA(0, 1, At, B1); PG8_BAR; PG8_SCHED;
            PG8_LDA(At, 1, 1); PG8_STAGE(PG8_SB(1, 0), b3, voffB); PG8_STAGE(PG8_SB(1, 1), b3 + hstep, voffB); PG8_STAGE(PG8_SA(1, 0), a3, voffA);
            PG8_WAIT_V(8); PG8_WAIT_L(0); PG8_BAR; PG8_MMA(1, 0, At, B0); PG8_MMA(1, 1, At, B1); PG8_BAR; PG8_SCHED;
            } else {
            PG8_LDB(B0, 0, 0); PG8_SCHED; PG8_LDA(At, 0, 0); PG8_STAGE(PG8_SA(1, 1), a1 + hstep, voffA);
            PG8_WAIT_L(8); PG8_BAR; PG8_WAIT_L(0); PG8_MMA(0, 0, At, B0); PG8_BAR; PG8_SCHED;
            PG8_LDB(B1, 0, 1); PG8_STAGE(PG8_SB(0, 0), b2, voffB);
            PG8_BAR; PG8_WAIT_L(0); PG8_MMA(0, 1, At, B1); PG8_BAR;
            PG8_LDA(At, 0, 1); PG8_STAGE(PG8_SA(0, 0), a2, voffA);
            PG8_BAR; PG8_WAIT_L(0); PG8_MMA(1, 0, At, B0); PG8_BAR; PG8_SCHED;
            PG8_STAGE(PG8_SB(0, 1), b2 + hstep, voffB);
            PG8_WAIT_V(6); PG8_BAR; PG8_MMA(1, 1, At, B1); PG8_BAR;
            PG8_LDB(B0, 1, 0); PG8_SCHED; PG8_LDA(At, 1, 0); PG8_STAGE(PG8_SA(0, 1), a2 + hstep, voffA);
            PG8_WAIT_L(8); PG8_BAR; PG8_WAIT_L(0); PG8_MMA(0, 0, At, B0); PG8_BAR; PG8_SCHED;
            PG8_LDB(B1, 1, 1); PG8_STAGE(PG8_SB(1, 0), b3, voffB);
            PG8_BAR; PG8_WAIT_L(0); PG8_MMA(0, 1, At, B1); PG8_BAR;
            PG8_LDA(At, 1, 1); PG8_STAGE(PG8_SA(1, 0), a3, voffA);
            PG8_BAR; PG8_WAIT_L(0); PG8_MMA(1, 0, At, B0); PG8_BAR; PG8_SCHED;
            PG8_STAGE(PG8_SB(1, 1), b3 + hstep, voffB);
            PG8_WAIT_V(6); PG8_BAR; PG8_MMA(1, 1, At, B1); PG8_BAR;
            }
        }
        if constexpr (ALIGN_EPI) { if (wr == 0) PG8_BAR; }
        if constexpr (!Epi::AFTER_DRAIN) { int lz2 = 0; asm volatile("" : "+v"(lz2)); const int le = (int)__builtin_amdgcn_mbcnt_hi(~0u, __builtin_amdgcn_mbcnt_lo(~0u, (unsigned)lz2));
            E(acc, cur, wr, wc, le & 15, le >> 4); if constexpr (Epi::TWICE) { asm volatile("" ::: "memory"); E.again(acc, cur, wr, wc, le & 15, le >> 4); } S.done(cur); }
        if (!has_next) break;
#pragma unroll
        for (int a = 0; a < 2; ++a)
#pragma unroll
            for (int b = 0; b < 2; ++b)
#pragma unroll
                for (int m = 0; m < 4; ++m)
#pragma unroll
                    for (int n = 0; n < 2; ++n) acc[a][b][m][n] = (f32x4){0.f, 0.f, 0.f, 0.f};
        cur = nxt; cA = nA; cB = nB; ++ui;
        if constexpr (ALIGN_EPI) { if (wr == 1) PG8_BAR; }
    }
    PG8_WAIT_V(0);
    if constexpr (!ALIGN_EPI) { if (wr == 0) PG8_BAR; }
    PG8_BAR;
    if constexpr (Epi::AFTER_DRAIN) { E.fused(acc, cur, wr, wc, fr, fq, lds, wid, lane); S.done(cur); }
#undef PG8_SA
#undef PG8_SB
#undef PG8_STAGE
#undef PG8_LDA
#undef PG8_LDB
#undef PG8_MMA
#undef PG8_WAIT_V
#undef PG8_WAIT_V_RELAX
#undef PG8_WAIT_L
#undef PG8_BAR
#undef PG8_SCHED
}
}
#define GAS __attribute__((address_space(1)))
#define LAS __attribute__((address_space(3)))
typedef unsigned short bf16;
typedef unsigned v4u __attribute__((ext_vector_type(4)));
typedef unsigned v2u __attribute__((ext_vector_type(2)));
typedef float f32x4 __attribute__((ext_vector_type(4)));
typedef short bf16x8 __attribute__((ext_vector_type(8)));
#define LDS_WAIT() asm volatile("s_waitcnt lgkmcnt(0)" ::: "memory")
__device__ __forceinline__ unsigned f2bf(float f) { unsigned u = __builtin_bit_cast(unsigned, f); return (u + 0x7fffu + ((u >> 16) & 1u)) >> 16; }
__device__ __forceinline__ unsigned pk2(float lo, float hi) { return f2bf(lo) | (f2bf(hi) << 16); }
__device__ __forceinline__ void st16_wt(void* p, v4u v) { *(v4u*)p = v; }
__device__ __forceinline__ void st8_wt(void* p, v2u v) { *(v2u*)p = v; }
__device__ __forceinline__ void st16f_wt(void* p, f32x4 v) { *(f32x4*)p = v; }
#define XB_TMO      128
#define XB_XCNT(j)  (256  + 64 * (j))
#define XB_XSUB(j)  (1280 + 64 * (j))
#define XB_XGEN(j)  (2304 + 64 * (j))
#define XB_TOP      3328
#define XB_TOPGEN   3392
#define XCD_BAR_WORDS 3456
#define XB_SPIN_CAP (1u << 18)

__device__ __forceinline__ unsigned xb_ld(unsigned* p)              { return __hip_atomic_load(p, __ATOMIC_RELAXED, __HIP_MEMORY_SCOPE_AGENT); }
__device__ __forceinline__ unsigned xb_add(unsigned* p, unsigned v) { return __hip_atomic_fetch_add(p, v, __ATOMIC_RELAXED, __HIP_MEMORY_SCOPE_AGENT); }
__device__ __forceinline__ unsigned xb_xcc_id() { return (unsigned)__builtin_amdgcn_s_getreg((3 << 11) | 20) & 0xFu; }
#define XB_SPIN(cond, bar) do { unsigned _sp = 0; while (cond) { __builtin_amdgcn_s_sleep(1); \
    if ((++_sp & 255u) == 0u) { if (xb_ld(&(bar)[XB_TMO])) break; if (_sp > XB_SPIN_CAP) { atomicAdd(&(bar)[XB_TMO], 1u); break; } } } } while (0)

struct XcdBarrier {
    unsigned* bar; unsigned x;
    volatile LAS unsigned* st;
};

__device__ __forceinline__ XcdBarrier xcd_barrier_post(unsigned* bar, volatile LAS unsigned* st) {
    XcdBarrier b; b.bar = bar; b.x = xb_xcc_id(); b.st = st;
    if (threadIdx.x == 0) (void)xb_add(&bar[XB_XCNT(b.x)], 1u);
    return b;
}
__device__ __forceinline__ void xcd_barrier_complete(unsigned* bar, unsigned x, unsigned& nloc, unsigned& nx) {
    const unsigned G = gridDim.x * gridDim.y * gridDim.z;
    unsigned sum, cnt, mine, sp = 0u;
    for (;;) {
        sum = 0u; cnt = 0u; mine = 0u;
#pragma unroll
        for (unsigned j = 0; j < 16; ++j) { const unsigned c = xb_ld(&bar[XB_XCNT(j)]); sum += c; cnt += (c > 0u) ? 1u : 0u; mine = (j == x) ? c : mine; }
        if (sum == G) break;
        __builtin_amdgcn_s_sleep(1);
        if ((++sp & 255u) == 0u) { if (xb_ld(&bar[XB_TMO])) break; if (sp > XB_SPIN_CAP) { atomicAdd(&bar[XB_TMO], 1u); break; } }
    }
    nloc = mine > 0u ? mine : 1u; nx = cnt > 0u ? cnt : 1u;
}

__device__ __forceinline__ void xcd_barrier(const XcdBarrier& b) {
    asm volatile("s_waitcnt vmcnt(0)" ::: "memory");
    __syncthreads();
    if (threadIdx.x == 0) {
        unsigned* bar = b.bar;
        __builtin_amdgcn_s_waitcnt(0);
        unsigned nloc = b.st[0], nx = b.st[1];
        if (nloc == 0u) { xcd_barrier_complete(bar, b.x, nloc, nx); b.st[0] = nloc; b.st[1] = nx; }
        const unsigned old = xb_add(&bar[XB_XSUB(b.x)], 1u);
        const unsigned gen = old / nloc;
        if (old + 1u == (gen + 1u) * nloc) {
            __builtin_amdgcn_fence(__ATOMIC_RELEASE, "agent");
            asm volatile("s_waitcnt vmcnt(0)" ::: "memory");
            const unsigned og = xb_add(&bar[XB_TOP], 1u);
            const unsigned tg = og / nx;
            if (og + 1u == (tg + 1u) * nx) xb_add(&bar[XB_TOPGEN], 1u);
            else XB_SPIN(xb_ld(&bar[XB_TOPGEN]) == tg, bar);
            __builtin_amdgcn_fence(__ATOMIC_ACQUIRE, "agent");
            xb_add(&bar[XB_XGEN(b.x)], 1u);
            asm volatile("s_waitcnt vmcnt(0)" ::: "memory");
        } else {
            XB_SPIN(xb_ld(&bar[XB_XGEN(b.x)]) == gen, bar);
            __builtin_amdgcn_fence(__ATOMIC_ACQUIRE, "agent");
            asm volatile("s_waitcnt vmcnt(0)" ::: "memory");
        }
    }
    __syncthreads();
}


constexpr int T = 16384, D = 1024, FF = 2816, NIN = 5632, NAB = 2560, MODW = 9216;
constexpr float EPS = 1e-6f;
constexpr size_t MiB = 1u << 20;
constexpr size_t WS_CTL = 0, CTL_ZERO_BYTES = 64 * 1024;
constexpr int CW_BAR = 1024;
constexpr size_t WS_MOD = 1 * MiB;
constexpr size_t WS_GK = 2 * MiB;
constexpr size_t WS_GATE = 2 * MiB + 256 * 1024;
constexpr size_t WS_RGK = 2 * MiB + 512 * 1024;
constexpr size_t WS_BIAS = 3 * MiB;
constexpr size_t BIAS_STRIDE_F = 65536;
constexpr size_t WS_ROWSS = 5 * MiB;
constexpr size_t WS_WS = 6 * MiB;
constexpr size_t WS_WGT = 6 * MiB + 512 * 1024;
constexpr size_t WS_HALOP = 7 * MiB;
constexpr size_t WS_VSTAT = 7 * MiB + 512 * 1024;
constexpr int CW_XCC = 512, CW_BAD = 448;
constexpr int CW_GRP = 8192;
constexpr size_t WS_WIN = 8 * MiB;
constexpr size_t WS_WOUT = 52 * MiB;
constexpr size_t WS_ABIN = 74 * MiB;
constexpr size_t WS_ABOUT = 79 * MiB;
constexpr size_t WS_XB = 82 * MiB;
constexpr size_t WS_YMIX = 114 * MiB;
constexpr size_t WS_ACT = 146 * MiB;
constexpr size_t WS_X2 = 236 * MiB;
constexpr size_t WS_END = 300 * MiB;

constexpr int RING_BYTES = 131072, LDSCTL_OFF = RING_BYTES, MISC_OFF = LDSCTL_OFF + 320, LDS_BYTES = 147456;

__device__ __forceinline__ float wave_sum(float v) {
#pragma unroll
    for (int o = 1; o < 64; o <<= 1) v += __shfl_xor(v, o);
    return v;
}
__device__ __forceinline__ float bflo(unsigned u) { return __uint_as_float(u << 16); }
__device__ __forceinline__ float bfhi(unsigned u) { return __uint_as_float(u & 0xffff0000u); }
__device__ __forceinline__ float silu_f(float x) { return x * __builtin_amdgcn_rcpf(1.f + __builtin_amdgcn_exp2f(-1.44269504f * x)); }
__device__ __forceinline__ float gelu_tanh_f(float x) { const float u = 0.7978845608f * (x + 0.044715f * x * x * x); return x * __builtin_amdgcn_rcpf(1.f + __builtin_amdgcn_exp2f(-2.88539008f * u)); }
__device__ __forceinline__ f32x4 mfma16(bf16x8 a, bf16x8 b, f32x4 c) { return __builtin_amdgcn_mfma_f32_16x16x32_bf16(a, b, c, 0, 0, 0); }

#ifndef PROBE_SWIGLU2
#define PROBE_SWIGLU2 0
#endif
#ifndef PROBE_RESID2
#define PROBE_RESID2 0
#endif
struct EpiSwiglu {
    static constexpr bool PERM = true, AFTER_DRAIN = false, TWICE = PROBE_SWIGLU2; static constexpr int NST = TWICE ? 0 : 8;
    bf16* O; const float* rowss; const float* bias;
    __device__ __forceinline__ void again(const f32x4 (&acc)[2][2][4][2], const pg8::Unit& u, int wr, int wc, int fr, int fq) const { (*this)(acc, u, wr, wc, fr, fq); }
    __device__ __forceinline__ void operator()(const f32x4 (&acc)[2][2][4][2], const pg8::Unit& u, int wr, int wc, int fr, int fq) const {
        const int b = u.pm >> 3;
        const float* bp = bias + b * NIN + u.pn * 256 + wc * 32 + 8 * fq;
        f32x4 bg[2], bu[2], bgl[2];
#pragma unroll
        for (int n = 0; n < 2; ++n) { bg[n] = *(const f32x4*)(bp + 4 * n); bu[n] = *(const f32x4*)(bp + 128 + 4 * n); bgl[n] = bg[n] * -1.44269504f; }
        const int hid0 = u.pn * 128 + wc * 32 + 8 * fq;
        float rsv[8];
#pragma unroll
        for (int q = 0; q < 8; ++q) rsv[q] = rowss[u.pm * 256 + (q >> 2) * 128 + wr * 64 + (q & 3) * 16 + fr];
        asm volatile("" ::: "memory");
#pragma unroll
        for (int ai = 0; ai < 2; ++ai)
#pragma unroll
            for (int m = 0; m < 4; ++m) {
                const int row = u.pm * 256 + ai * 128 + wr * 64 + m * 16 + fr;
                const float rs = rsqrtf(rsv[ai * 4 + m] * (1.f / 1024.f) + EPS);
                v4u w; const float k1 = -1.44269504f * rs;
#pragma unroll
                for (int n = 0; n < 2; ++n) {
                    const f32x4 g = acc[ai][0][m][n] * rs + bg[n], t = acc[ai][0][m][n] * k1 + bgl[n], uu = acc[ai][1][m][n] * rs + bu[n];
                    f32x4 e; e[0] = __builtin_amdgcn_exp2f(t[0]); e[1] = __builtin_amdgcn_exp2f(t[1]); e[2] = __builtin_amdgcn_exp2f(t[2]); e[3] = __builtin_amdgcn_exp2f(t[3]);
                    e = e + 1.f;
                    f32x4 r; r[0] = __builtin_amdgcn_rcpf(e[0]); r[1] = __builtin_amdgcn_rcpf(e[1]); r[2] = __builtin_amdgcn_rcpf(e[2]); r[3] = __builtin_amdgcn_rcpf(e[3]);
                    const f32x4 a = (g * uu) * r;
                    if (n == 0) { w.x = pg8::cvt_pk_bf16(a[0], a[1]); w.y = pg8::cvt_pk_bf16(a[2], a[3]); } else { w.z = pg8::cvt_pk_bf16(a[0], a[1]); w.w = pg8::cvt_pk_bf16(a[2], a[3]); }
                }
                st16_wt(O + (size_t)row * FF + hid0, w);
            }
    }
};
struct EpiProj {
    static constexpr bool PERM = true, AFTER_DRAIN = false, TWICE = false; static constexpr int NST = 16;
    bf16* O; const float* rowss; const float* bias; bf16* halo; float* vstat;
    __device__ __forceinline__ void operator()(const f32x4 (&acc)[2][2][4][2], const pg8::Unit& u, int wr, int wc, int fr, int fq) const {
        const int b = u.pm >> 3; const int col0 = u.pn * 256 + wc * 32 + 8 * fq;
        const float* bp = bias + b * NAB + col0;
        f32x4 bv[2][2];
#pragma unroll
        for (int bj = 0; bj < 2; ++bj)
#pragma unroll
            for (int n = 0; n < 2; ++n) bv[bj][n] = *(const f32x4*)(bp + 128 * bj + 4 * n);
        const bool act = u.pn < 4;
        float rsv[8];
#pragma unroll
        for (int q = 0; q < 8; ++q) rsv[q] = rowss[u.pm * 256 + (q >> 2) * 128 + wr * 64 + (q & 3) * 16 + fr];
        asm volatile("" ::: "memory");
#pragma unroll
        for (int ai = 0; ai < 2; ++ai)
#pragma unroll
            for (int m = 0; m < 4; ++m) {
                const int row = u.pm * 256 + ai * 128 + wr * 64 + m * 16 + fr;
                const float rs = rsqrtf(rsv[ai * 4 + m] * (1.f / 1024.f) + EPS);
                float s1 = 0.f, s2 = 0.f;
#pragma unroll
                for (int bj = 0; bj < 2; ++bj) {
                    f32x4 v0 = acc[ai][bj][m][0] * rs + bv[bj][0], v1 = acc[ai][bj][m][1] * rs + bv[bj][1];
                    if (act) {
#pragma unroll
                        for (int j = 0; j < 4; ++j) { v0[j] = gelu_tanh_f(v0[j]); v1[j] = gelu_tanh_f(v1[j]); }
                        s1 += ((v0[0] + v0[1]) + (v0[2] + v0[3])) + ((v1[0] + v1[1]) + (v1[2] + v1[3]));
                        s2 += ((v0[0] * v0[0] + v0[1] * v0[1]) + (v0[2] * v0[2] + v0[3] * v0[3])) + ((v1[0] * v1[0] + v1[1] * v1[1]) + (v1[2] * v1[2] + v1[3] * v1[3])); }
                    v4u w; w.x = pg8::cvt_pk_bf16(v0[0], v0[1]); w.y = pg8::cvt_pk_bf16(v0[2], v0[3]); w.z = pg8::cvt_pk_bf16(v1[0], v1[1]); w.w = pg8::cvt_pk_bf16(v1[2], v1[3]);
                    st16_wt(O + (size_t)row * NAB + col0 + 128 * bj, w);
                    if (ai == 1 && m == 3) { if (wr == 1 && fr >= 14 && u.pn >= 6) *(v4u*)(halo + (size_t)(u.pm * 2 + (fr - 14)) * 1024 + (col0 + 128 * bj - 1536)) = w; }
                }
                if (u.pn == 2 || u.pn == 3) {
                    s1 += __shfl_xor(s1, 16); s1 += __shfl_xor(s1, 32); s2 += __shfl_xor(s2, 16); s2 += __shfl_xor(s2, 32);
                    if (fq == 0) { (void)__hip_atomic_fetch_add(vstat + 2 * row, s1, __ATOMIC_RELAXED, __HIP_MEMORY_SCOPE_AGENT); (void)__hip_atomic_fetch_add(vstat + 2 * row + 1, s2, __ATOMIC_RELAXED, __HIP_MEMORY_SCOPE_AGENT); }
                }
            }
    }
};
struct EpiNull {
    static constexpr bool PERM = true, AFTER_DRAIN = false, TWICE = false; static constexpr int NST = 0;
    __device__ __forceinline__ void operator()(const f32x4 (&acc)[2][2][4][2], const pg8::Unit& u, int wr, int wc, int fr, int fq) const {
#pragma unroll
        for (int ai = 0; ai < 2; ++ai)
#pragma unroll
            for (int bj = 0; bj < 2; ++bj)
#pragma unroll
                for (int m = 0; m < 4; ++m)
#pragma unroll
                    for (int n = 0; n < 2; ++n) asm volatile("" :: "v"(acc[ai][bj][m][n]));
    }
};
struct EpiResid {
    static constexpr bool PERM = true, AFTER_DRAIN = false, TWICE = false; static constexpr int NST = 0;
    const bf16* xin_b; const float* rgk_old; const float* gate; float* rowss_next; const float* gk_next; bf16* xb; float* xout;
    __device__ __forceinline__ void operator()(const f32x4 (&acc)[2][2][4][2], const pg8::Unit& u, int wr, int wc, int fr, int fq) const {
        const int b = u.pm >> 3; const int col0 = u.pn * 256 + wc * 32 + 8 * fq;
        f32x4 gt[2][2], gk[2][2], rg[2][2];
#pragma unroll
        for (int bj = 0; bj < 2; ++bj)
#pragma unroll
            for (int n = 0; n < 2; ++n) {
                gt[bj][n] = *(const f32x4*)(gate + b * 1024 + col0 + 128 * bj + 4 * n);
                gk[bj][n] = gk_next ? *(const f32x4*)(gk_next + b * 1024 + col0 + 128 * bj + 4 * n) : (f32x4){0.f, 0.f, 0.f, 0.f};
                rg[bj][n] = *(const f32x4*)(rgk_old + b * 1024 + col0 + 128 * bj + 4 * n);
            }
        v4u xq[8][2];
#define EPI_LOADG(gq_) do { const int row_ = u.pm * 256 + ((gq_) >> 2) * 128 + wr * 64 + ((gq_) & 3) * 16 + fr; const bf16* p_ = xin_b + (size_t)row_ * D + col0; \
            xq[gq_][0] = *(const v4u*)(p_); xq[gq_][1] = *(const v4u*)(p_ + 128); } while (0)
        EPI_LOADG(0); EPI_LOADG(1); EPI_LOADG(2);
#pragma unroll
        for (int gq = 0; gq < 8; ++gq) {
            if (gq + 3 < 8) EPI_LOADG(gq + 3);
            asm volatile("" ::: "memory");
            const int ai = gq >> 2, m = gq & 3;
            const int row = u.pm * 256 + ai * 128 + wr * 64 + m * 16 + fr;
            float ss = 0.f;
#pragma unroll
            for (int bj = 0; bj < 2; ++bj) {
                const size_t off = (size_t)row * D + col0 + 128 * bj;
                const v4u rw = xq[gq][bj];
                f32x4 x0 = (f32x4){bflo(rw.x), bfhi(rw.x), bflo(rw.y), bfhi(rw.y)} * rg[bj][0], x1 = (f32x4){bflo(rw.z), bfhi(rw.z), bflo(rw.w), bfhi(rw.w)} * rg[bj][1];
                x0 += gt[bj][0] * acc[ai][bj][m][0]; x1 += gt[bj][1] * acc[ai][bj][m][1];
                ss += (x0[0] * x0[0] + x0[1] * x0[1]) + (x0[2] * x0[2] + x0[3] * x0[3]) + (x1[0] * x1[0] + x1[1] * x1[1]) + (x1[2] * x1[2] + x1[3] * x1[3]);
                if (gk_next) { const f32x4 y0 = x0 * gk[bj][0], y1 = x1 * gk[bj][1];
                    v4u w; w.x = pg8::cvt_pk_bf16(y0[0], y0[1]); w.y = pg8::cvt_pk_bf16(y0[2], y0[3]); w.z = pg8::cvt_pk_bf16(y1[0], y1[1]); w.w = pg8::cvt_pk_bf16(y1[2], y1[3]);
                    st16_wt(xb + off, w); }
                else { st16f_wt(xout + off, x0); st16f_wt(xout + off + 4, x1); }
            }
            ss += __shfl_xor(ss, 16); ss += __shfl_xor(ss, 32);
            if (fq == 0) (void)__hip_atomic_fetch_add(rowss_next + row, ss, __ATOMIC_RELAXED, __HIP_MEMORY_SCOPE_AGENT);
            asm volatile("" ::: "memory");
        }
#undef EPI_LOADG
    }
};

__device__ __forceinline__ void group_barrier(unsigned* cnt, unsigned& k, int same_xcc);
struct EpiResidFinal {
    static constexpr bool PERM = true, AFTER_DRAIN = false, TWICE = false; static constexpr int NST = 0;
    const bf16* xin_b; const float* rgk_old; const float* gate; float* rowss; const float* final_g; float* out; unsigned* gcnt; unsigned& gk; int same_xcc;
    __device__ __forceinline__ void operator()(f32x4 (&acc)[2][2][4][2], const pg8::Unit& u, int wr, int wc, int fr, int fq) const {
        const int b = u.pm >> 3; const int col0 = u.pn * 256 + wc * 32 + 8 * fq;
        {
            f32x4 gt[2][2], rg[2][2];
#pragma unroll
            for (int bj = 0; bj < 2; ++bj)
#pragma unroll
                for (int n = 0; n < 2; ++n) { gt[bj][n] = *(const f32x4*)(gate + b * 1024 + col0 + 128 * bj + 4 * n); rg[bj][n] = *(const f32x4*)(rgk_old + b * 1024 + col0 + 128 * bj + 4 * n); }
            v4u xq[8][2];
#define EPI_LOADG(gq_) do { const int row_ = u.pm * 256 + ((gq_) >> 2) * 128 + wr * 64 + ((gq_) & 3) * 16 + fr; const bf16* p_ = xin_b + (size_t)row_ * D + col0; \
            xq[gq_][0] = *(const v4u*)(p_); xq[gq_][1] = *(const v4u*)(p_ + 128); } while (0)
            EPI_LOADG(0); EPI_LOADG(1); EPI_LOADG(2);
#pragma unroll
            for (int gq = 0; gq < 8; ++gq) {
                if (gq + 3 < 8) EPI_LOADG(gq + 3);
                asm volatile("" ::: "memory");
                const int ai = gq >> 2, m = gq & 3; const int row = u.pm * 256 + ai * 128 + wr * 64 + m * 16 + fr;
                float ss = 0.f;
#pragma unroll
                for (int bj = 0; bj < 2; ++bj) {
                    const v4u rw = xq[gq][bj];
                    f32x4 x0 = (f32x4){bflo(rw.x), bfhi(rw.x), bflo(rw.y), bfhi(rw.y)} * rg[bj][0], x1 = (f32x4){bflo(rw.z), bfhi(rw.z), bflo(rw.w), bfhi(rw.w)} * rg[bj][1];
                    x0 += gt[bj][0] * acc[ai][bj][m][0]; x1 += gt[bj][1] * acc[ai][bj][m][1];
                    acc[ai][bj][m][0] = x0; acc[ai][bj][m][1] = x1;
                    ss += (x0[0] * x0[0] + x0[1] * x0[1]) + (x0[2] * x0[2] + x0[3] * x0[3]) + (x1[0] * x1[0] + x1[1] * x1[1]) + (x1[2] * x1[2] + x1[3] * x1[3]);
                }
                ss += __shfl_xor(ss, 16); ss += __shfl_xor(ss, 32);
                if (fq == 0) (void)__hip_atomic_fetch_add(rowss + row, ss, __ATOMIC_RELAXED, __HIP_MEMORY_SCOPE_AGENT);
            }
#undef EPI_LOADG
        }
        group_barrier(gcnt, gk, same_xcc);
        f32x4 fg[2][2]; float rsv[8];
#pragma unroll
        for (int bj = 0; bj < 2; ++bj)
#pragma unroll
            for (int n = 0; n < 2; ++n) fg[bj][n] = *(const f32x4*)(final_g + col0 + 128 * bj + 4 * n);
#pragma unroll
        for (int q = 0; q < 8; ++q) rsv[q] = __hip_atomic_load(rowss + u.pm * 256 + (q >> 2) * 128 + wr * 64 + (q & 3) * 16 + fr, __ATOMIC_RELAXED, __HIP_MEMORY_SCOPE_AGENT);
#pragma unroll
        for (int gq = 0; gq < 8; ++gq) {
            const int ai = gq >> 2, m = gq & 3; const int row = u.pm * 256 + ai * 128 + wr * 64 + m * 16 + fr;
            const float rs = rsqrtf(rsv[gq] * (1.f / 1024.f) + EPS);
#pragma unroll
            for (int bj = 0; bj < 2; ++bj) {
                const size_t off = (size_t)row * D + col0 + 128 * bj;
                *(f32x4*)(out + off) = acc[ai][bj][m][0] * rs * fg[bj][0]; *(f32x4*)(out + off + 4) = acc[ai][bj][m][1] * rs * fg[bj][1];
            }
        }
    }
};

__device__ __forceinline__ void transpose_item(const float* W, int K, int N, bf16* WT, int mode, LAS float* scr, int item, int lane) {
    const int nblk = N / 32, kb = item / nblk, nb = item % nblk, k0 = 64 * kb, n0 = 32 * nb;
    int drow0 = n0;
    if (mode == 1) { const int j = n0 < FF ? n0 : n0 - FF; drow0 = (j >> 7) * 256 + (j & 127) + (n0 < FF ? 0 : 128); }
#pragma unroll 8
    for (int i = 0; i < 32; ++i) { const int kk = 2 * i + (lane >> 5); scr[kk * 33 + (lane & 31)] = W[(size_t)(k0 + kk) * N + n0 + (lane & 31)]; }
    LDS_WAIT(); asm volatile("" ::: "memory");
    const int c = lane & 7;
#pragma unroll
    for (int j = 0; j < 4; ++j) { const int n = (lane >> 3) + 8 * j; const LAS float* s = scr + (8 * c) * 33 + n;
        v4u o; o.x = pk2(s[0 * 33], s[1 * 33]); o.y = pk2(s[2 * 33], s[3 * 33]); o.z = pk2(s[4 * 33], s[5 * 33]); o.w = pk2(s[6 * 33], s[7 * 33]);
        *(v4u*)(WT + (size_t)(drow0 + n) * K + k0 + 8 * c) = o; }
    LDS_WAIT(); asm volatile("" ::: "memory");
}
__device__ __forceinline__ void mod_task(const float* c, const float* w_mod, const float* b_mod, float* MOD, LAS float* fl, int task, int tid, int wave, int lane) {
    const int l = task / 72, cgp = task % 72;
    for (int i = tid; i < 8192; i += 512) { const float v = c[i]; fl[i] = v / (1.f + __expf(-v)); }
    __syncthreads();
    const int col = cgp * 128 + lane * 2;
    const float* wp = w_mod + (size_t)l * D * MODW + (size_t)(wave * 128) * MODW + col;
    float acc[8][2];
#pragma unroll
    for (int b = 0; b < 8; ++b) { acc[b][0] = 0.f; acc[b][1] = 0.f; }
#pragma unroll 16
    for (int k = 0; k < 128; ++k) {
        const float2 w = *(const float2*)(wp + (size_t)k * MODW);
#pragma unroll
        for (int b = 0; b < 8; ++b) { const float cv = fl[b * 1024 + wave * 128 + k]; acc[b][0] += cv * w.x; acc[b][1] += cv * w.y; }
    }
#pragma unroll
    for (int b = 0; b < 8; ++b) { fl[8192 + (wave * 8 + b) * 128 + lane * 2] = acc[b][0]; fl[8192 + (wave * 8 + b) * 128 + lane * 2 + 1] = acc[b][1]; }
    __syncthreads();
    for (int o = tid; o < 1024; o += 512) { const int b = o >> 7, cc = o & 127; float s = 0.f;
#pragma unroll
        for (int w = 0; w < 8; ++w) s += fl[8192 + (w * 8 + b) * 128 + cc];
        MOD[(size_t)(l * 8 + b) * MODW + cgp * 128 + cc] = s + b_mod[l * MODW + cgp * 128 + cc]; }
    __syncthreads();
}
__device__ __forceinline__ bf16x8 pack8(const float (&v)[8]) {
    v4u o; o.x = pk2(v[0], v[1]); o.y = pk2(v[2], v[3]); o.z = pk2(v[4], v[5]); o.w = pk2(v[6], v[7]);
    return __builtin_bit_cast(bf16x8, o);
}

__device__ __forceinline__ void mid_phase(const bf16* PROJ, bf16* YMIX, const bf16* WST, const float* norm_v, const float* b_s, const float* conv_w, const bf16* HALOP, const float* VSTAT,
                                          LAS unsigned char* lds, int pm, int g, int wave_in, int lane_in) {
    LAS bf16* vT = (LAS bf16*)lds; constexpr int VS = 136;
#pragma clang loop unroll(disable)
    for (int q = 0; q < 2; ++q) {
        int lane = lane_in; asm volatile("" : "+v"(lane));
        int wave = wave_in; asm volatile("" : "+s"(wave));
        const int fr = lane & 15, fq = lane >> 4;
        const int cidx = 2 * pm + (g >> 1), h = 2 * (g & 1) + q, tok0 = cidx * 128;
        {
            const int hl = lane & 15, rsub = lane >> 4;
            float nv[8];
#pragma unroll
            for (int j = 0; j < 8; ++j) nv[j] = norm_v[128 * h + 8 * hl + j];
            v4u rawv[4]; float st1[4], st2[4];
#pragma unroll
            for (int it = 0; it < 4; ++it) { const int t = tok0 + 16 * wave + 4 * it + rsub; rawv[it] = *(const v4u*)(PROJ + (size_t)t * NAB + 512 + 128 * h + 8 * hl); st1[it] = VSTAT[2 * t]; st2[it] = VSTAT[2 * t + 1]; }
#pragma unroll
            for (int it = 0; it < 4; ++it) {
                const int s = 16 * wave + 4 * it + rsub; const v4u raw = rawv[it];
                float f[8]; f[0] = bflo(raw.x); f[1] = bfhi(raw.x); f[2] = bflo(raw.y); f[3] = bfhi(raw.y); f[4] = bflo(raw.z); f[5] = bfhi(raw.z); f[6] = bflo(raw.w); f[7] = bfhi(raw.w);
                const float mean = st1[it] * (1.f / 512.f), var = fmaxf(st2[it] * (1.f / 512.f) - mean * mean, 0.f), rs = rsqrtf(var + EPS);
#pragma unroll
                for (int j = 0; j < 8; ++j) vT[(8 * hl + j) * VS + s] = (bf16)f2bf((f[j] - mean) * rs * nv[j]);
            }
        }
        __syncthreads();
        f32x4 acc[8];
#pragma unroll
        for (int d = 0; d < 8; ++d) acc[d] = (f32x4){0.f, 0.f, 0.f, 0.f};
        const int t0 = 16 * wave, kkmax = (t0 + 15) >> 5;
        for (int kk = 0; kk <= kkmax; ++kk) {
            const bf16x8 wf = *(const bf16x8*)(WST + (size_t)(h * 128 + t0 + fr) * 128 + 32 * kk + 8 * fq);
#pragma unroll
            for (int d = 0; d < 8; ++d) { const bf16x8 vf = *(const LAS bf16x8*)(vT + (16 * d + fr) * VS + 32 * kk + 8 * fq); acc[d] = mfma16(vf, wf, acc[d]); }
        }
        {
            const int t = tok0 + t0 + fr; const float zb = b_s[h * 128 + t0 + fr];
#pragma unroll
            for (int d = 0; d < 8; ++d) {
                const int col = 128 * h + 16 * d + 4 * fq;
                const v2u gu = *(const v2u*)(PROJ + (size_t)t * NAB + col);
                const float y0 = bflo(gu.x) * (acc[d][0] + zb), y1 = bfhi(gu.x) * (acc[d][1] + zb), y2 = bflo(gu.y) * (acc[d][2] + zb), y3 = bfhi(gu.y) * (acc[d][3] + zb);
                v2u w; w.x = pk2(y0, y1); w.y = pk2(y2, y3);
                st8_wt(YMIX + (size_t)t * D + col, w);
            }
        }
        {
            const int tf = tok0 + 32 * h + 4 * wave; const bool halo = (tf & 2047) != 0; const int c = 8 * lane;
            float w0[8], w1[8], w2[8], pm2[8], pm1[8];
#pragma unroll
            for (int j = 0; j < 8; ++j) { w0[j] = conv_w[c + j]; w1[j] = conv_w[512 + c + j]; w2[j] = conv_w[1024 + c + j]; pm2[j] = 0.f; pm1[j] = 0.f; }
            if (halo) {
                const bool nb = (tf & 255) == 0;
                const bf16* p2 = nb ? HALOP + (size_t)((pm - 1) * 2 + 0) * 1024 + c - 1536 : PROJ + (size_t)(tf - 2) * NAB + c;
                const bf16* p1 = nb ? HALOP + (size_t)((pm - 1) * 2 + 1) * 1024 + c - 1536 : PROJ + (size_t)(tf - 1) * NAB + c;
                const v4u a2 = *(const v4u*)(p2 + 1536), b2 = *(const v4u*)(p2 + 2048), a1 = *(const v4u*)(p1 + 1536), b1 = *(const v4u*)(p1 + 2048);
                pm2[0] = bflo(a2.x) * bflo(b2.x); pm2[1] = bfhi(a2.x) * bfhi(b2.x); pm2[2] = bflo(a2.y) * bflo(b2.y); pm2[3] = bfhi(a2.y) * bfhi(b2.y);
                pm2[4] = bflo(a2.z) * bflo(b2.z); pm2[5] = bfhi(a2.z) * bfhi(b2.z); pm2[6] = bflo(a2.w) * bflo(b2.w); pm2[7] = bfhi(a2.w) * bfhi(b2.w);
                pm1[0] = bflo(a1.x) * bflo(b1.x); pm1[1] = bfhi(a1.x) * bfhi(b1.x); pm1[2] = bflo(a1.y) * bflo(b1.y); pm1[3] = bfhi(a1.y) * bfhi(b1.y);
                pm1[4] = bflo(a1.z) * bflo(b1.z); pm1[5] = bfhi(a1.z) * bfhi(b1.z); pm1[6] = bflo(a1.w) * bflo(b1.w); pm1[7] = bfhi(a1.w) * bfhi(b1.w);
            }
#pragma unroll
            for (int r = 0; r < 4; ++r) {
                const bf16* pr = PROJ + (size_t)(tf + r) * NAB + c;
                const v4u g = *(const v4u*)(pr + 1024), a = *(const v4u*)(pr + 1536), x = *(const v4u*)(pr + 2048);
                float cur[8], bgv[8], y[8];
                cur[0] = bflo(a.x) * bflo(x.x); cur[1] = bfhi(a.x) * bfhi(x.x); cur[2] = bflo(a.y) * bflo(x.y); cur[3] = bfhi(a.y) * bfhi(x.y);
                cur[4] = bflo(a.z) * bflo(x.z); cur[5] = bfhi(a.z) * bfhi(x.z); cur[6] = bflo(a.w) * bflo(x.w); cur[7] = bfhi(a.w) * bfhi(x.w);
                bgv[0] = bflo(g.x); bgv[1] = bfhi(g.x); bgv[2] = bflo(g.y); bgv[3] = bfhi(g.y); bgv[4] = bflo(g.z); bgv[5] = bfhi(g.z); bgv[6] = bflo(g.w); bgv[7] = bfhi(g.w);
#pragma unroll
                for (int j = 0; j < 8; ++j) { y[j] = bgv[j] * (w0[j] * pm2[j] + w1[j] * pm1[j] + w2[j] * cur[j]); pm2[j] = pm1[j]; pm1[j] = cur[j]; }
                v4u o; o.x = pk2(y[0], y[1]); o.y = pk2(y[2], y[3]); o.z = pk2(y[4], y[5]); o.w = pk2(y[6], y[7]);
                st16_wt(YMIX + (size_t)(tf + r) * D + 512 + c, o);
            }
        }
        __syncthreads();
    }
}

constexpr int PS = 264;
template <int W> __device__ __forceinline__ void pool_build(const bf16* XBI, const float* rowss, const float* shp, LAS bf16* P, int tile0, int g, int wave, int lane) {
    const int c = 256 * g + 4 * lane, trow0 = tile0 + 16 * wave, tpos0 = trow0 & 2047;
    const f32x4 sh = *(const f32x4*)(shp + c);
    f32x4 ring[W];
#pragma unroll
    for (int r = -(W - 1); r < 16; ++r) {
        const int t = trow0 + r; const bool valid = (tpos0 + r) >= 0;
        f32x4 hv = (f32x4){0.f, 0.f, 0.f, 0.f};
        if (valid) { const float rs = rsqrtf(rowss[t] * (1.f / 1024.f) + EPS); const v2u xr = *(const v2u*)(XBI + (size_t)t * D + c); hv = (f32x4){bflo(xr.x), bfhi(xr.x), bflo(xr.y), bfhi(xr.y)} * rs + sh; }
        ring[(r + 16) % W] = hv;
        if (r >= 0) {
            f32x4 S = ring[0];
#pragma unroll
            for (int q = 1; q < W; ++q) S += ring[q];
            const float inv = (tpos0 == 0 && (r + 1) < W) ? (1.f / (float)(r + 1)) : (1.f / (float)W);
            const f32x4 p = S * inv - hv;
            v2u o; o.x = pk2(p[0], p[1]); o.y = pk2(p[2], p[3]);
            *(LAS v2u*)(P + (16 * wave + r) * PS + 4 * lane) = o;
        }
        if (((r + 16) & 7) == 7) asm volatile("" ::: "memory");
    }
}
__device__ __forceinline__ void pool_phase(const bf16* XBI, bf16* XBO, const float* rowss4, float* rowss5, const float* rgk4, const float* shift4, const float* gate4, const float* gk5,
                                           const bf16* WGT, LAS unsigned char* lds, int pm, int gi, int wave_in, int lane_in) {
    LAS bf16* P = (LAS bf16*)lds;
#pragma clang loop unroll(disable)
    for (int q = 0; q < 2; ++q) {
        int lane = lane_in; asm volatile("" : "+v"(lane));
        int wave = wave_in; asm volatile("" : "+s"(wave));
        const int fr = lane & 15, fq = lane >> 4;
        const int tile = 2 * pm + (gi >> 1), g = 2 * (gi & 1) + q, tile0 = tile * 128, b = tile0 >> 11;
        const float* shp = shift4 + (size_t)b * MODW;
        if (g == 0) pool_build<2>(XBI, rowss4, shp, P, tile0, g, wave, lane);
        else if (g == 1) pool_build<4>(XBI, rowss4, shp, P, tile0, g, wave, lane);
        else if (g == 2) pool_build<8>(XBI, rowss4, shp, P, tile0, g, wave, lane);
        else pool_build<16>(XBI, rowss4, shp, P, tile0, g, wave, lane);
        __syncthreads();
        f32x4 acc[8][2];
#pragma unroll
        for (int tb = 0; tb < 8; ++tb) { acc[tb][0] = (f32x4){0.f, 0.f, 0.f, 0.f}; acc[tb][1] = (f32x4){0.f, 0.f, 0.f, 0.f}; }
        const int colb = 256 * g + 32 * wave + 4 * fq;
        v2u xr[8][2];
#pragma unroll
        for (int tb = 0; tb < 8; ++tb)
#pragma unroll
            for (int nb = 0; nb < 2; ++nb) xr[tb][nb] = *(const v2u*)(XBI + (size_t)(tile0 + 16 * tb + fr) * D + colb + 16 * nb);
        const bf16* wbase = WGT + (size_t)(g * 256 + 32 * wave + fr) * 256 + 8 * fq;
#pragma unroll
        for (int kk = 0; kk < 8; ++kk) {
            const bf16x8 wf0 = *(const bf16x8*)(wbase + 32 * kk), wf1 = *(const bf16x8*)(wbase + 16 * 256 + 32 * kk);
#pragma unroll
            for (int tb = 0; tb < 8; ++tb) {
                const bf16x8 pf = *(const LAS bf16x8*)(P + (16 * tb + fr) * PS + 32 * kk + 8 * fq);
                acc[tb][0] = mfma16(wf0, pf, acc[tb][0]); acc[tb][1] = mfma16(wf1, pf, acc[tb][1]);
            }
        }
        f32x4 gt[2], gk[2], rg[2];
#pragma unroll
        for (int nb = 0; nb < 2; ++nb) { gt[nb] = *(const f32x4*)(gate4 + b * 1024 + colb + 16 * nb); gk[nb] = *(const f32x4*)(gk5 + b * 1024 + colb + 16 * nb); rg[nb] = *(const f32x4*)(rgk4 + b * 1024 + colb + 16 * nb); }
        asm volatile("" ::: "memory");
#pragma unroll
        for (int tb = 0; tb < 8; ++tb) {
            const int t = tile0 + 16 * tb + fr; float ss = 0.f;
#pragma unroll
            for (int nb = 0; nb < 2; ++nb) {
                const size_t off = (size_t)t * D + colb + 16 * nb;
                f32x4 xv = (f32x4){bflo(xr[tb][nb].x), bfhi(xr[tb][nb].x), bflo(xr[tb][nb].y), bfhi(xr[tb][nb].y)} * rg[nb]; xv += gt[nb] * acc[tb][nb];
                ss += (xv[0] * xv[0] + xv[1] * xv[1]) + (xv[2] * xv[2] + xv[3] * xv[3]);
                const f32x4 y = xv * gk[nb]; v2u o; o.x = pg8::cvt_pk_bf16(y[0], y[1]); o.y = pg8::cvt_pk_bf16(y[2], y[3]);
                st8_wt(XBO + off, o);
            }
            ss += __shfl_xor(ss, 16); ss += __shfl_xor(ss, 32);
            if (fq == 0) (void)__hip_atomic_fetch_add(rowss5 + t, ss, __ATOMIC_RELAXED, __HIP_MEMORY_SCOPE_AGENT);
        }
        __syncthreads();
    }
}

#define GB_SPIN_CAP (1u << 22)
__device__ __forceinline__ void group_wait_t0(unsigned* cnt, unsigned want) {
    unsigned sp = 0u;
    while (__hip_atomic_load(cnt, __ATOMIC_RELAXED, __HIP_MEMORY_SCOPE_AGENT) < want) { __builtin_amdgcn_s_sleep(1); if (++sp > GB_SPIN_CAP) break; }
    __builtin_amdgcn_fence(__ATOMIC_ACQUIRE, "agent");
    asm volatile("s_waitcnt vmcnt(0)" ::: "memory");
}
__device__ __forceinline__ void group_barrier(unsigned* cnt, unsigned& k, int same_xcc) {
    asm volatile("s_waitcnt vmcnt(0)" ::: "memory");
    __syncthreads();
    if (threadIdx.x == 0) {
        if (!same_xcc) { __builtin_amdgcn_fence(__ATOMIC_RELEASE, "agent");
        asm volatile("s_waitcnt vmcnt(0)" ::: "memory"); }
        (void)__hip_atomic_fetch_add(cnt, 1u, __ATOMIC_RELAXED, __HIP_MEMORY_SCOPE_AGENT);
        asm volatile("buffer_inv sc1" ::: "memory");
        const unsigned want = 4u * (k + 1u); unsigned sp = 0u;
        while (__hip_atomic_load(cnt, __ATOMIC_RELAXED, __HIP_MEMORY_SCOPE_AGENT) < want) { __builtin_amdgcn_s_sleep(1); if (++sp > GB_SPIN_CAP) break; }
        asm volatile("s_waitcnt vmcnt(0)" ::: "memory");
    }
    ++k;
    __syncthreads();
}
__device__ __forceinline__ void neighbour_wait(unsigned* cnt, unsigned want) {
    if (threadIdx.x == 0) group_wait_t0(cnt, want);
    __syncthreads();
}

__device__ __forceinline__ int lane_now() { int z = 0; asm volatile("" : "+v"(z)); return (int)__builtin_amdgcn_mbcnt_hi(~0u, __builtin_amdgcn_mbcnt_lo(~0u, (unsigned)z)); }
struct Args { const float* in[16]; float* out; unsigned char* ws; int never; int pad; };
typedef const __attribute__((address_space(4))) Args* KArgs;
__device__ __forceinline__ KArgs kargs() { KArgs p = (KArgs)__builtin_amdgcn_kernarg_segment_ptr(); asm volatile("" : "+s"(p)); return p; }

__global__ void __launch_bounds__(512, 2) fwd_mega(Args a) {
    extern __shared__ __attribute__((aligned(16))) unsigned char lds_raw[];
    LAS unsigned char* lds = (LAS unsigned char*)lds_raw;
    const int wave = __builtin_amdgcn_readfirstlane((int)threadIdx.x >> 6);
#define lane (lane_now())
#define tid (wave * 64 + lane_now())
    const int G = gridDim.x, bx = blockIdx.x;
    const int gw = bx * 8 + wave, NGW = G * 8;
    for (int u = tid; u < (LDS_BYTES - LDSCTL_OFF) / 4; u += 512) ((LAS unsigned*)(lds + LDSCTL_OFF))[u] = 0u;
    __syncthreads();
    XcdBarrier bar = xcd_barrier_post((unsigned*)(kargs()->ws + WS_CTL) + CW_BAR, (volatile LAS unsigned*)(lds + MISC_OFF) + 8);
    if (kargs()->never) cg::this_grid().sync();
#define GRID_BAR() xcd_barrier(bar)
    const int pm_g = 8 * (bx & 7) + ((bx >> 3) & 7), gi = bx >> 6;
    unsigned gk_n = 0u;
#define GCNT(p) ((unsigned*)(kargs()->ws + WS_CTL) + CW_GRP + 64 * (p))
#ifndef PROBE_BAR2
#define PROBE_BAR2 0
#endif
#define GROUP_BAR() do { group_barrier(GCNT(pm_g), gk_n, same_xcc); if (PROBE_BAR2) group_barrier(GCNT(pm_g), gk_n, same_xcc); } while (0)
#define HALOP ((bf16*)WSP(WS_HALOP))
#define VSTAT ((float*)WSP(WS_VSTAT))
#define IN_(i) (kargs()->in[i])
#define WSP(off) (kargs()->ws + (off))
#define x_in IN_(0)
#define c_in IN_(1)
#define norm_g IN_(2)
#define w_mod IN_(3)
#define b_mod IN_(4)
#define w_ffn_in IN_(5)
#define w_ffn_out IN_(6)
#define ab_w_in IN_(7)
#define ab_norm_v IN_(8)
#define ab_w_s IN_(9)
#define ab_b_s IN_(10)
#define ab_conv_w IN_(11)
#define ab_w_out IN_(12)
#define pool_w_grp IN_(13)
#define pool_scale IN_(14)
#define final_g IN_(15)
#define out (kargs()->out)
#define MOD ((float*)WSP(WS_MOD))
#define GK ((float*)WSP(WS_GK))
#define GATE ((float*)WSP(WS_GATE))
#define BIAS ((float*)WSP(WS_BIAS))
#define ROWSS ((float*)WSP(WS_ROWSS))
#define WST ((bf16*)WSP(WS_WS))
#define WGT ((bf16*)WSP(WS_WGT))
#define WIN ((bf16*)WSP(WS_WIN))
#define WOUT ((bf16*)WSP(WS_WOUT))
#define ABIN ((bf16*)WSP(WS_ABIN))
#define ABOUT ((bf16*)WSP(WS_ABOUT))
#define XB ((bf16*)WSP(WS_XB))
#define YMIX ((bf16*)WSP(WS_YMIX))
#define ACT ((bf16*)WSP(WS_ACT))
#define XB2 ((bf16*)WSP(WS_X2))
#define RGK ((float*)WSP(WS_RGK))

    if (threadIdx.x == 0) __hip_atomic_store((unsigned*)(kargs()->ws + WS_CTL) + CW_XCC + bx, 1u + xb_xcc_id(), __ATOMIC_RELAXED, __HIP_MEMORY_SCOPE_AGENT);
    {
#ifndef PROBE_MOD2
#define PROBE_MOD2 0
#endif
#pragma clang loop unroll(disable)
        for (int rep = 0; rep < 1 + PROBE_MOD2; ++rep)
        if (bx < 144) mod_task(c_in, w_mod, b_mod, MOD, (LAS float*)lds, bx, tid, wave, lane);
        LAS float* scr = (LAS float*)(lds + wave * 16384);
        constexpr int I_IN = 16 * 176, I_OUT = 44 * 32, I_ABIN = 16 * 80, I_ABOUT = 16 * 32, I_PG = 4 * 8;
        constexpr int NITEMS = 4 * I_IN + 4 * I_OUT + I_ABIN + I_ABOUT + 4 * I_PG;
#ifndef PROBE_P0A2
#define PROBE_P0A2 0
#endif
        constexpr int NX = (NITEMS * 764) / 1000;
#pragma clang loop unroll(disable)
        for (int rep = 0; rep < 2 * (1 + PROBE_P0A2); ++rep) {
        const bool second = (rep & 1) != 0;
        if (second && bx < 144) continue;
        const int it0 = second ? NX + (gw - 144 * 8) : gw, its = second ? 112 * 8 : NGW, ite = second ? NITEMS : NX;
        for (int it = it0; it < ite; it += its) {
            int r = it;
            if (r < 4 * I_IN) { const int q = r / I_IN; r -= q * I_IN; transpose_item(w_ffn_in + (size_t)q * D * NIN, D, NIN, WIN + (size_t)q * NIN * D, 1, scr, r, lane); continue; } r -= 4 * I_IN;
            if (r < 4 * I_OUT) { const int q = r / I_OUT; r -= q * I_OUT; transpose_item(w_ffn_out + (size_t)q * FF * D, FF, D, WOUT + (size_t)q * D * FF, 0, scr, r, lane); continue; } r -= 4 * I_OUT;
            if (r < I_ABIN) { transpose_item(ab_w_in, D, NAB, ABIN, 0, scr, r, lane); continue; } r -= I_ABIN;
            if (r < I_ABOUT) { transpose_item(ab_w_out, D, D, ABOUT, 0, scr, r, lane); continue; } r -= I_ABOUT;
            { const int q = r / I_PG; r -= q * I_PG; transpose_item(pool_w_grp + (size_t)q * 65536, 256, 256, WGT + (size_t)q * 65536, 0, scr, r, lane); }
        }
        }
        for (int i = bx * 512 + tid; i < 4 * 128 * 128; i += G * 512) { const int s = i & 127, t = (i >> 7) & 127; WST[i] = (s <= t) ? (bf16)f2bf(ab_w_s[i]) : (bf16)0; }
        for (int i = bx * 512 + tid; i < 6 * T; i += G * 512) ROWSS[T + i] = 0.f;
        for (int i = bx * 512 + tid; i < 2 * T; i += G * 512) VSTAT[i] = 0.f;
    }
    GRID_BAR();
    if (threadIdx.x == 0) {
        const unsigned mine = 1u + xb_xcc_id(), ref = __hip_atomic_load((unsigned*)(kargs()->ws + WS_CTL) + CW_XCC + (bx & 7), __ATOMIC_RELAXED, __HIP_MEMORY_SCOPE_AGENT);
        if (ref != mine) (void)__hip_atomic_fetch_add((unsigned*)(kargs()->ws + WS_CTL) + CW_BAD, 1u, __ATOMIC_RELAXED, __HIP_MEMORY_SCOPE_AGENT);
    }
#ifndef PROBE_P0B2
#define PROBE_P0B2 0
#endif
#pragma clang loop unroll(disable)
    for (int rep = 0; rep < 1 + PROBE_P0B2; ++rep)
    {
        for (int idx = bx * 512 + tid; idx < 6 * 8 * 1024; idx += G * 512) {
            const int i = idx >> 13, b = (idx >> 10) & 7, k = idx & 1023, l = i / 3, s = i - 3 * l;
            const float* mb = MOD + (size_t)(l * 8 + b) * MODW + s * 3072;
            const float gkv = norm_g[i * 1024 + k] * (1.f + mb[1024 + k]);
            GK[idx] = gkv; RGK[idx] = 1.f / gkv;
            float g = mb[2048 + k] * (s == 1 ? 1.f : 0.5f); if (i == 4) g *= pool_scale[k];
            GATE[idx] = g;
        }
        constexpr int BT_IN = NIN / 16, BT_AB = NAB / 16, NBT = 4 * BT_IN + BT_AB;
        const int fr = lane & 15, fq = lane >> 4;
        for (int tk = gw; tk < NBT; tk += NGW) {
            int g, r0, N, i; const bf16* Bt;
            if (tk < 4 * BT_IN) { g = tk / BT_IN; r0 = (tk - g * BT_IN) * 16; Bt = WIN + (size_t)g * NIN * D; N = NIN; i = (g >> 1) * 3 + (g & 1) * 2; }
            else { g = 4; r0 = (tk - 4 * BT_IN) * 16; Bt = ABIN; N = NAB; i = 1; }
            const int l = i / 3, s = i - 3 * l;
            const float* shp = MOD + (size_t)(l * 8 + (fr & 7)) * MODW + s * 3072 + 8 * fq;
            const bf16* ap = Bt + (size_t)(r0 + fr) * D + 8 * fq;
            f32x4 acc = (f32x4){0.f, 0.f, 0.f, 0.f};
#pragma unroll 4
            for (int kk = 0; kk < 32; ++kk) {
                const bf16x8 av = *(const bf16x8*)(ap + 32 * kk);
                const f32x4 s0 = *(const f32x4*)(shp + 32 * kk), s1 = *(const f32x4*)(shp + 32 * kk + 4);
                float hi[8], lo[8];
#pragma unroll
                for (int j = 0; j < 4; ++j) { hi[j] = __uint_as_float(f2bf(s0[j]) << 16); lo[j] = s0[j] - hi[j]; hi[4 + j] = __uint_as_float(f2bf(s1[j]) << 16); lo[4 + j] = s1[j] - hi[4 + j]; }
                acc = mfma16(av, pack8(hi), acc); acc = mfma16(av, pack8(lo), acc);
            }
            if (fr < 8) *(f32x4*)(BIAS + (size_t)g * BIAS_STRIDE_F + (size_t)fr * N + r0 + 4 * fq) = acc;
        }
        for (int m0 = gw * 4; m0 < T; m0 += NGW * 4) {
            const int b = m0 >> 11; const float* mb = MOD + (size_t)b * MODW + 1024;
            f32x4 v[4][4]; f32x4 gkv[4];
#pragma unroll
            for (int r = 0; r < 4; ++r)
#pragma unroll
                for (int j = 0; j < 4; ++j) v[r][j] = *(const f32x4*)(x_in + (size_t)(m0 + r) * D + 4 * lane + 256 * j);
#pragma unroll
            for (int j = 0; j < 4; ++j) { const int c = 4 * lane + 256 * j; gkv[j] = *(const f32x4*)(norm_g + c) * (*(const f32x4*)(mb + c) + 1.f); }
            asm volatile("" ::: "memory");
#pragma unroll
            for (int r = 0; r < 4; ++r) {
                float ss = 0.f;
#pragma unroll
                for (int j = 0; j < 4; ++j) ss += (v[r][j][0] * v[r][j][0] + v[r][j][1] * v[r][j][1]) + (v[r][j][2] * v[r][j][2] + v[r][j][3] * v[r][j][3]);
                ss = wave_sum(ss); if (lane == 0) ROWSS[m0 + r] = ss;
#pragma unroll
                for (int j = 0; j < 4; ++j) { const f32x4 y = v[r][j] * gkv[j]; v2u o; o.x = pk2(y[0], y[1]); o.y = pk2(y[2], y[3]); *(v2u*)(XB + (size_t)(m0 + r) * D + 4 * lane + 256 * j) = o; }
            }
        }
    }
    GRID_BAR();
    int same_xcc;
    {
        volatile LAS unsigned* fl = (volatile LAS unsigned*)(lds + MISC_OFF) + 12;
        if (threadIdx.x == 0) fl[0] = (__hip_atomic_load((unsigned*)(kargs()->ws + WS_CTL) + CW_BAD, __ATOMIC_RELAXED, __HIP_MEMORY_SCOPE_AGENT) == 0u && G == 256) ? 1u : 0u;
        __syncthreads();
        same_xcc = __builtin_amdgcn_readfirstlane((int)fl[0]);
    }
#ifndef STAG_TICKS
#define STAG_TICKS 0
#endif
    if (STAG_TICKS > 0) {
        const unsigned long long t0 = __builtin_amdgcn_s_memrealtime(); const unsigned long long d = (unsigned long long)STAG_TICKS * (unsigned)(pm_g & 7);
        while (__builtin_amdgcn_s_memrealtime() - t0 < d) __builtin_amdgcn_s_sleep(16);
    }
#pragma clang loop unroll(disable)
    for (int f = 0; f < 4; ++f) {
        const int l = f >> 1, i = 3 * l + 2 * (f & 1);
#ifndef PROBE_FIN2
#define PROBE_FIN2 0
#endif
#pragma clang loop unroll(disable)
        for (int rep = 0; rep < 1 + PROBE_FIN2; ++rep)
        {
            pg8::Gemm g{f == 3 ? XB2 : XB, WIN + (size_t)f * NIN * D, T, NIN, D}; pg8::StaticOrder S; S.init(T, NIN, G, bx);
            EpiSwiglu E{ACT, ROWSS + (size_t)i * T, BIAS + (size_t)f * BIAS_STRIDE_F};
            pg8::gemm_phase<EpiSwiglu, pg8::StaticOrder, true, true>(lds, g, S, E, wave);
        }
        GROUP_BAR();
#ifndef PROBE_FOUTK
#define PROBE_FOUTK 0
#endif
        if (f < 3) {
            pg8::Gemm g{ACT, WOUT + (size_t)f * D * FF, T, D, FF}; pg8::StaticOrder S; S.init(T, D, G, bx);
            EpiResid E{XB, RGK + (size_t)i * 8192, GATE + (size_t)i * 8192, ROWSS + (size_t)(i + 1) * T, GK + (size_t)(i + 1) * 8192, XB, out};
            pg8::gemm_phase<EpiResid, pg8::StaticOrder, true, true>(lds, g, S, E, wave);
        } else {
            pg8::Gemm g{ACT, WOUT + (size_t)f * D * FF, T, D, FF}; pg8::StaticOrder S; S.init(T, D, G, bx);
            EpiResidFinal E{XB2, RGK + (size_t)i * 8192, GATE + (size_t)i * 8192, ROWSS + (size_t)(i + 1) * T, final_g, out, GCNT(pm_g), gk_n, same_xcc};
            pg8::gemm_phase<EpiResidFinal, pg8::StaticOrder, true, true>(lds, g, S, E, wave);
            break;
        }
        GROUP_BAR();
        if (f == 0) {
#ifndef PROBE_MIN2
#define PROBE_MIN2 0
#endif
#pragma clang loop unroll(disable)
            for (int rep = 0; rep < 1 + PROBE_MIN2; ++rep)
            {
                pg8::Gemm g{XB, ABIN, T, NAB, D}; pg8::StaticOrder S; S.init(T, NAB, G, bx);
                EpiProj E{ACT, ROWSS + (size_t)1 * T, BIAS + (size_t)4 * BIAS_STRIDE_F, HALOP, VSTAT};
                pg8::gemm_phase<EpiProj, pg8::StaticOrder, true, true>(lds, g, S, E, wave);
            }
            GROUP_BAR();
            if ((pm_g & 7) != 0 && gi == 0) neighbour_wait(GCNT(pm_g - 1), 4u * gk_n);
#ifndef PROBE_MID2
#define PROBE_MID2 0
#endif
#pragma clang loop unroll(disable)
            for (int rep = 0; rep < 1 + PROBE_MID2; ++rep)
            mid_phase(ACT, YMIX, WST, ab_norm_v, ab_b_s, ab_conv_w, HALOP, VSTAT, lds, pm_g, gi, wave, lane);
            GROUP_BAR();
            {
                pg8::Gemm g{YMIX, ABOUT, T, D, D}; pg8::StaticOrder S; S.init(T, D, G, bx);
                EpiResid E{XB, RGK + (size_t)1 * 8192, GATE + (size_t)1 * 8192, ROWSS + (size_t)2 * T, GK + (size_t)2 * 8192, XB, out};
                pg8::gemm_phase<EpiResid, pg8::StaticOrder, true, true>(lds, g, S, E, wave);
            }
            GROUP_BAR();
        } else if (f == 2) {
            if ((pm_g & 7) != 0 && gi < 2) neighbour_wait(GCNT(pm_g - 1), 4u * gk_n);
            pool_phase(XB, XB2, ROWSS + (size_t)4 * T, ROWSS + (size_t)5 * T, RGK + (size_t)4 * 8192, MOD + (size_t)8 * MODW + 3072, GATE + (size_t)4 * 8192, GK + (size_t)5 * 8192,
                       WGT, lds, pm_g, gi, wave, lane);
            GROUP_BAR();
        }
    }
}

#undef tid
#undef lane
#undef GRID_BAR
#undef GROUP_BAR
#undef GCNT
#undef HALOP
#undef VSTAT
#undef IN_
#undef WSP
#undef x_in
#undef c_in
#undef norm_g
#undef w_mod
#undef b_mod
#undef w_ffn_in
#undef w_ffn_out
#undef ab_w_in
#undef ab_norm_v
#undef ab_w_s
#undef ab_b_s
#undef ab_conv_w
#undef ab_w_out
#undef pool_w_grp
#undef pool_scale
#undef final_g
#undef out
#undef MOD
#undef GK
#undef GATE
#undef BIAS
#undef ROWSS
#undef WST
#undef WGT
#undef WIN
#undef WOUT
#undef ABIN
#undef ABOUT
#undef XB
#undef YMIX
#undef ACT
#undef XB2
#undef RGK

extern "C" void kernel_launch(void* const* d_in, const int* in_sizes, int n_in, void* d_out, int out_size, void* d_ws, size_t ws_size, hipStream_t stream) {
    static int grid = 0;
    if (grid == 0) {
        if (n_in != 16 || in_sizes[0] != T * D || out_size != T * D || ws_size < WS_END) { fprintf(stderr, "kernel_launch: unexpected shapes (n_in %d, in0 %d, out %d, ws %zu)\n", n_in, n_in > 0 ? in_sizes[0] : -1, out_size, ws_size); grid = -1; return; }
        int dev = 0, cus = 0, per_cu = 0;
        if (hipGetDevice(&dev) != hipSuccess || hipDeviceGetAttribute(&cus, hipDeviceAttributeMultiprocessorCount, dev) != hipSuccess) { grid = -1; return; }
        if (hipFuncSetAttribute((const void*)fwd_mega, hipFuncAttributeMaxDynamicSharedMemorySize, LDS_BYTES) != hipSuccess) { fprintf(stderr, "kernel_launch: hipFuncSetAttribute failed\n"); grid = -1; return; }
        if (hipOccupancyMaxActiveBlocksPerMultiprocessor(&per_cu, (const void*)fwd_mega, 512, LDS_BYTES) != hipSuccess || per_cu < 1) { fprintf(stderr, "kernel_launch: occupancy query says %d blocks per CU\n", per_cu); per_cu = 1; }
        (void)hipGetLastError();
        if (cus < 256) { fprintf(stderr, "kernel_launch: built for a 256-CU device (got %d CUs)\n", cus); grid = -1; return; }
        grid = 256;
    }
    if (grid < 0) return;
    (void)hipMemsetAsync((char*)d_ws + WS_CTL, 0, CTL_ZERO_BYTES, stream);
    Args a{};
    for (int i = 0; i < 16; ++i) a.in[i] = (const float*)d_in[i];
    a.out = (float*)d_out; a.ws = (unsigned char*)d_ws; a.never = 0; a.pad = 0;
    void* args[] = {&a};
    const hipError_t e = hipLaunchCooperativeKernel((const void*)fwd_mega, dim3(grid), dim3(512), args, LDS_BYTES, stream);
    if (e != hipSuccess) fprintf(stderr, "kernel_launch: cooperative launch failed: %s (grid %d)\n", hipGetErrorString(e), grid);
}
```

```cpp
#include <hip/hip_runtime.h>
#include <hip/hip_cooperative_groups.h>
#include <cstdio>
#include <cstdint>
namespace cg = cooperative_groups;
namespace pg8 {
#define PG8_LAS __attribute__((address_space(3)))
typedef unsigned short bf16_t;
typedef short bf16x8 __attribute__((ext_vector_type(8)));
typedef float f32x4 __attribute__((ext_vector_type(4)));
typedef unsigned u32x4 __attribute__((ext_vector_type(4)));
constexpr int BM = 256, BK = 64, HALF = 128, HTB = HALF * BK * 2  , STAGE_BYTES = 8 * HTB, NXCD = 8, WGM = 8;

__host__ __device__ __forceinline__ int lds_byte(int r, int c) { const int st = (r >> 4) * 2 + (c >> 5), rr = r & 15, cc = c & 31, ob = rr * 64 + cc * 2; return st * 1024 + (ob ^ (((ob >> 9) & 1) << 5)); }
__host__ __device__ __forceinline__ void stage_rc(int b, int& R, int& C) { const int st = b / 1024, sb = b % 1024, swz = sb ^ (((sb >> 9) & 1) << 5); R = (st >> 1) * 16 + swz / 64; C = (st & 1) * 32 + (swz % 64) / 2; }
__host__ __device__ __forceinline__ int perm32(int rho) { const int n = rho >> 4, i = rho & 15; return 8 * (i >> 2) + 4 * n + (i & 3); }

struct Unit { int pm, pn, hsel, half; };
struct Gemm { const bf16_t* A; const bf16_t* Bt; int M, N, K; };

struct StaticOrder {
    int nM, nN, nwg, G, c;
    __host__ __device__ void init(int M, int N, int G_, int c_) { nM = M / BM; nN = N / BM; nwg = nM * nN; G = G_; c = c_; }
    __host__ __device__ bool next(int i, Unit& u) const {
        const long L = (long)i * G + c; if (L >= nwg) return false;
        int wgid = (int)L; { const int q = nwg / NXCD, r = nwg % NXCD, xcd = wgid % NXCD, off = wgid / NXCD; wgid = (xcd < r ? xcd * (q + 1) : r * (q + 1) + (xcd - r) * q) + off; }
        const int nig = WGM * nN, gid = wgid / nig, fm = gid * WGM, gsz = (nM - fm) < WGM ? (nM - fm) : WGM;
        u.pm = fm + ((wgid % nig) % gsz); u.pn = (wgid % nig) / gsz; u.hsel = 0; u.half = 0; return true;
    }
    __device__ __forceinline__ void a_ready(const Unit&) const {}
    __device__ __forceinline__ void done(const Unit&) const {}
};

__device__ __forceinline__ unsigned cvt_pk_bf16(float lo, float hi) { unsigned r; asm volatile("v_cvt_pk_bf16_f32 %0, %1, %2" : "=v"(r) : "v"(lo), "v"(hi)); return r; }
template <class Epi, class Sched, bool ALIGN_EPI = false, bool SP2 = false>
__device__ __forceinline__ void gemm_phase(PG8_LAS unsigned char* lds, const Gemm g, const Sched& S, const Epi& E, const int wave_id) {
    int lz = 0; asm volatile("" : "+v"(lz));
    const int lane_m = (int)__builtin_amdgcn_mbcnt_hi(~0u, __builtin_amdgcn_mbcnt_lo(~0u, (unsigned)lz));
    int wave_l = wave_id; asm volatile("" : "+s"(wave_l));
    const int tid = wave_l * 64 + lane_m, wid = wave_l, lane = lane_m, wr = wid >> 2, wc = wid & 3, fr = lane & 15, fq = lane >> 4;
    const int K = g.K, nt = K / BK;
    unsigned voffA[2], voffB[2];
#pragma unroll
    for (int i = 0; i < 2; ++i) { int R, C; stage_rc(tid * 16 + i * 8192, R, C); const int Rb = Epi::PERM ? ((R & ~31) + perm32(R & 31)) : R;
        voffA[i] = (unsigned)(R * K + C) * 2u; voffB[i] = (unsigned)(Rb * K + C) * 2u; }
    const size_t kstep = (size_t)(BK * 2);
    const size_t hstep = (size_t)HALF * K * 2;
    const size_t tstep = 2 * hstep;
    const unsigned ldsw = (unsigned)wid * 1024u;
    const int aoff = lds_byte(wr * 64 + fr, fq * 8), boff = lds_byte(wc * 32 + fr, fq * 8);
#define PG8_SA(b, h) (((b) * 2 + (h)) * HTB)
#define PG8_SB(b, h) ((4 + (b) * 2 + (h)) * HTB)
#define PG8_STAGE(bufoff, gbase, voff) do { _Pragma("unroll") for (int _i = 0; _i < 2; ++_i) \
        __builtin_amdgcn_global_load_lds((const unsigned*)((const char*)(gbase) + (voff)[_i]), (PG8_LAS unsigned*)(lds + (bufoff) + ldsw + _i * 8192), 16, 0, 0); } while (0)
#define PG8_LDA(dst, b, h) do { _Pragma("unroll") for (int m = 0; m < 4; ++m) _Pragma("unroll") for (int k = 0; k < 2; ++k) dst[m][k] = *(const PG8_LAS bf16x8*)(lds + PG8_SA(b, h) + aoff + m * 2048 + k * 1024); } while (0)
#define PG8_LDB(dst, b, h) do { _Pragma("unroll") for (int n = 0; n < 2; ++n) _Pragma("unroll") for (int k = 0; k < 2; ++k) dst[n][k] = *(const PG8_LAS bf16x8*)(lds + PG8_SB(b, h) + boff + n * 2048 + k * 1024); } while (0)
#define PG8_MMA(ai, bj, At, Bt) do { __builtin_amdgcn_s_setprio(1); _Pragma("unroll") for (int m = 0; m < 4; ++m) _Pragma("unroll") for (int n = 0; n < 2; ++n) _Pragma("unroll") for (int k = 0; k < 2; ++k) \
        acc[ai][bj][m][n] = __builtin_amdgcn_mfma_f32_16x16x32_bf16(Bt[n][k], At[m][k], acc[ai][bj][m][n], 0, 0, 0); __builtin_amdgcn_s_setprio(0); } while (0)
#define PG8_WAIT_V(n) asm volatile("s_waitcnt vmcnt(" #n ")" ::: "memory")
#define PG8_WAIT_V_RELAX(flag, nrel) asm volatile("s_cmp_lg_u32 %0, 0\n\ts_cbranch_scc1 .Lpg8rx%=\n\ts_waitcnt vmcnt(8)\n\ts_branch .Lpg8ry%=\n.Lpg8rx%=:\n\ts_waitcnt vmcnt(" #nrel ")\n.Lpg8ry%=:" :: "s"(flag) : "memory", "scc")
#define PG8_WAIT_L(n) asm volatile("s_waitcnt lgkmcnt(" #n ")" ::: "memory")
#define PG8_BAR __builtin_amdgcn_s_barrier()
#define PG8_SCHED __builtin_amdgcn_sched_barrier(0)
    Unit cur, nxt; int ui = 0;
    if (!S.next(0, cur)) return;
    f32x4 acc[2][2][4][2];
#pragma unroll
    for (int a = 0; a < 2; ++a)
#pragma unroll
        for (int b = 0; b < 2; ++b)
#pragma unroll
            for (int m = 0; m < 4; ++m)
#pragma unroll
                for (int n = 0; n < 2; ++n) acc[a][b][m][n] = (f32x4){0.f, 0.f, 0.f, 0.f};
    bf16x8 At[4][2], B0[2][2], B1[2][2];
    const char* cA = (const char*)g.A + (size_t)cur.pm * tstep; const char* cB = (const char*)g.Bt + (size_t)cur.pn * tstep;
    S.a_ready(cur);
    if constexpr (SP2) {
        PG8_STAGE(PG8_SB(0, 0), cB, voffB); PG8_STAGE(PG8_SB(0, 1), cB + hstep, voffB); PG8_STAGE(PG8_SA(0, 0), cA, voffA); PG8_STAGE(PG8_SA(0, 1), cA + hstep, voffA);
        if (wr == 1) PG8_BAR;
        PG8_WAIT_V(2); PG8_BAR;
        PG8_STAGE(PG8_SB(1, 0), cB + kstep, voffB); PG8_STAGE(PG8_SA(1, 0), cA + kstep, voffA); PG8_STAGE(PG8_SB(1, 1), cB + hstep + kstep, voffB);
        PG8_WAIT_V(6); PG8_BAR;
    } else {
        PG8_STAGE(PG8_SB(0, 0), cB, voffB); PG8_STAGE(PG8_SA(0, 0), cA, voffA); PG8_STAGE(PG8_SB(0, 1), cB + hstep, voffB); PG8_STAGE(PG8_SA(0, 1), cA + hstep, voffA);
        if (wr == 1) PG8_BAR;
        PG8_WAIT_V(4); PG8_BAR;
        PG8_STAGE(PG8_SB(1, 0), cB + kstep, voffB); PG8_STAGE(PG8_SA(1, 0), cA + kstep, voffA); PG8_STAGE(PG8_SB(1, 1), cB + hstep + kstep, voffB);
        PG8_WAIT_V(6); PG8_BAR;
    }
    for (;;) {
        const bool has_next = S.next(ui + 1, nxt);
        const char* nA = has_next ? (const char*)g.A + (size_t)nxt.pm * tstep : cA; const char* nB = has_next ? (const char*)g.Bt + (size_t)nxt.pn * tstep : cB;
        for (int t = 0; t < nt; t += 2) {
            const bool last = (t == nt - 2);
            const char* a1 = cA + (size_t)(t + 1) * kstep;
            const char* a2 = last ? nA : cA + (size_t)(t + 2) * kstep; const char* b2 = last ? nB : cB + (size_t)(t + 2) * kstep;
            const char* a3 = a2 + kstep; const char* b3 = b2 + kstep;
            if (last && has_next) S.a_ready(nxt);
            if constexpr (SP2) {
            PG8_LDB(B0, 0, 0); PG8_LDB(B1, 0, 1); PG8_SCHED; PG8_LDA(At, 0, 0); PG8_STAGE(PG8_SA(1, 1), a1 + hstep, voffA);
            PG8_WAIT_V(8); PG8_WAIT_L(0); PG8_BAR; PG8_MMA(0, 0, At, B0); PG8_MMA(0, 1, At, B1); PG8_BAR; PG8_SCHED;
            PG8_LDA(At, 0, 1); PG8_STAGE(PG8_SB(0, 0), b2, voffB); PG8_STAGE(PG8_SB(0, 1), b2 + hstep, voffB); PG8_STAGE(PG8_SA(0, 0), a2, voffA);
            PG8_WAIT_V(8); PG8_WAIT_L(0); PG8_BAR; PG8_MMA(1, 0, At, B0); PG8_MMA(1, 1, At, B1); PG8_BAR; PG8_SCHED;
            PG8_LDB(B0, 1, 0); PG8_LDB(B1, 1, 1); PG8_SCHED; PG8_LDA(At, 1, 0); PG8_STAGE(PG8_SA(0, 1), a2 + hstep, voffA);
            PG8_WAIT_V(8); PG8_WAIT_L(0); PG8_BAR; PG8_MMA(0, 0, At, B0); PG8_MMA(0, 1, At, B1); PG8_BAR; PG8_SCHED;
            PG8_LDA(At, 1, 1); PG8_STAGE(PG8_SB(1, 0), b3, voffB); PG8_STAGE(PG8_SB(1, 1), b3 + hstep, voffB); PG8_STAGE(PG8_SA(1, 0), a3, voffA);
            PG8_WAIT_V(8); PG8_WAIT_L(0); PG8_BAR; PG8_MMA(1, 0, At, B0); PG8_MMA(1, 1, At, B1); PG8_BAR; PG8_SCHED;
            } else {
            PG8_LDB(B0, 0, 0); PG8_SCHED; PG8_LDA(At, 0, 0); PG8_STAGE(PG8_SA(1, 1), a1 + hstep, voffA);
            PG8_WAIT_L(8); PG8_BAR; PG8_WAIT_L(0); PG8_MMA(0, 0, At, B0); PG8_BAR; PG8_SCHED;
            PG8_LDB(B1, 0, 1); PG8_STAGE(PG8_SB(0, 0), b2, voffB);
            PG8_BAR; PG8_WAIT_L(0); PG8_MMA(0, 1, At, B1); PG8_BAR;
            PG8_LDA(At, 0, 1); PG8_STAGE(PG8_SA(0, 0), a2, voffA);
            PG8_BAR; PG8_WAIT_L(0); PG8_MMA(1, 0, At, B0); PG8_BAR; PG8_SCHED;
            PG8_STAGE(PG8_SB(0, 1), b2 + hstep, voffB);
            PG8_WAIT_V(6); PG8_BAR; PG8_MMA(1, 1, At, B1); PG8_BAR;
            PG8_LDB(B0, 1, 0); PG8_SCHED; PG8_LDA(At, 1, 0); PG8_STAGE(PG8_SA(0, 1), a2 + hstep, voffA);
            PG8_WAIT_L(8); PG8_BAR; PG8_WAIT_L(0); PG8_MMA(0, 0, At, B0); PG8_BAR; PG8_SCHED;
            PG8_LDB(B1, 1, 1); PG8_STAGE(PG8_SB(1, 0), b3, voffB);
            PG8_BAR; PG8_WAIT_L(0); PG8_MMA(0, 1, At, B1); PG8_BAR;
            PG8_LDA(At, 1, 1); PG8_STAGE(PG8_SA(1, 0), a3, voffA);
            PG8_BAR; PG8_WAIT_L(0); PG8_MMA(1, 0, At, B0); PG8_BAR; PG8_SCHED;
            PG8_STAGE(PG8_SB(1, 1), b3 + hstep, voffB);
            PG8_WAIT_V(6); PG8_BAR; PG8_MMA(1, 1, At, B1); PG8_BAR;
            }
        }
        if constexpr (ALIGN_EPI) { if (wr == 0) PG8_BAR; }
        if constexpr (!Epi::AFTER_DRAIN) { int lz2 = 0; asm volatile("" : "+v"(lz2)); const int le = (int)__builtin_amdgcn_mbcnt_hi(~0u, __builtin_amdgcn_mbcnt_lo(~0u, (unsigned)lz2));
            E(acc, cur, wr, wc, le & 15, le >> 4); if constexpr (Epi::TWICE) { asm volatile("" ::: "memory"); E.again(acc, cur, wr, wc, le & 15, le >> 4); } S.done(cur); }
        if (!has_next) break;
#pragma unroll
        for (int a = 0; a < 2; ++a)
#pragma unroll
            for (int b = 0; b < 2; ++b)
#pragma unroll
                for (int m = 0; m < 4; ++m)
#pragma unroll
                    for (int n = 0; n < 2; ++n) acc[a][b][m][n] = (f32x4){0.f, 0.f, 0.f, 0.f};
        cur = nxt; cA = nA; cB = nB; ++ui;
        if constexpr (ALIGN_EPI) { if (wr == 1) PG8_BAR; }
    }
    PG8_WAIT_V(0);
    if constexpr (!ALIGN_EPI) { if (wr == 0) PG8_BAR; }
    PG8_BAR;
    if constexpr (Epi::AFTER_DRAIN) { E.fused(acc, cur, wr, wc, fr, fq, lds, wid, lane); S.done(cur); }
#undef PG8_SA
#undef PG8_SB
#undef PG8_STAGE
#undef PG8_LDA
#undef PG8_LDB
#undef PG8_MMA
#undef PG8_WAIT_V
#undef PG8_WAIT_V_RELAX
#undef PG8_WAIT_L
#undef PG8_BAR
#undef PG8_SCHED
}

template <class Epi>
__device__ __forceinline__ void gemm_half(PG8_LAS unsigned char* lds, const bf16_t* A, const bf16_t* Bt, const int K, const Unit u, const Epi& E, const int wave_id) {
    int lz = 0; asm volatile("" : "+v"(lz));
    const int lane = (int)__builtin_amdgcn_mbcnt_hi(~0u, __builtin_amdgcn_mbcnt_lo(~0u, (unsigned)lz));
    int wave_l = wave_id; asm volatile("" : "+s"(wave_l));
    const int tid = wave_l * 64 + lane, wid = wave_l, wr = wid >> 2, wc = wid & 3, fr = lane & 15, fq = lane >> 4;
    const int nt = K / BK;
    unsigned voffA[2], voffB[2];
#pragma unroll
    for (int i = 0; i < 2; ++i) { int R, C; stage_rc(tid * 16 + i * 8192, R, C); const int Rb = Epi::PERM ? ((R & ~31) + perm32(R & 31)) : R;
        voffA[i] = (unsigned)(R * K + C) * 2u; voffB[i] = (unsigned)(Rb * K + C) * 2u; }
    const size_t kstep = (size_t)(BK * 2), hstep = (size_t)HALF * K * 2;
    const unsigned ldsw = (unsigned)wid * 1024u;
    const int aoff = lds_byte(wr * 64 + fr, fq * 8), boff = lds_byte(wc * 32 + fr, fq * 8);
    const char* cA = (const char*)A + ((size_t)u.pm * 256 + (size_t)u.hsel * 128) * (size_t)K * 2;
    const char* cB = (const char*)Bt + (size_t)u.pn * 2 * hstep;
#define PGH_STAGE(bufoff, gbase, voff) do { _Pragma("unroll") for (int _i = 0; _i < 2; ++_i) \
        __builtin_amdgcn_global_load_lds((const unsigned*)((const char*)(gbase) + (voff)[_i]), (PG8_LAS unsigned*)(lds + (bufoff) + ldsw + _i * 8192), 16, 0, 0); } while (0)
    f32x4 acc[2][2][4][2];
#pragma unroll
    for (int a = 0; a < 2; ++a)
#pragma unroll
        for (int b = 0; b < 2; ++b)
#pragma unroll
            for (int m = 0; m < 4; ++m)
#pragma unroll
                for (int n = 0; n < 2; ++n) acc[a][b][m][n] = (f32x4){0.f, 0.f, 0.f, 0.f};
    bf16x8 At[2][4][2], B0[2][2][2], B1[2][2][2];
#define PGH_READ(fb, so) do { _Pragma("unroll") for (int n = 0; n < 2; ++n) _Pragma("unroll") for (int k = 0; k < 2; ++k) { \
            B0[fb][n][k] = *(const PG8_LAS bf16x8*)(lds + (so) + boff + n * 2048 + k * 1024); B1[fb][n][k] = *(const PG8_LAS bf16x8*)(lds + (so) + HTB + boff + n * 2048 + k * 1024); } \
        _Pragma("unroll") for (int m = 0; m < 4; ++m) _Pragma("unroll") for (int k = 0; k < 2; ++k) At[fb][m][k] = *(const PG8_LAS bf16x8*)(lds + (so) + 2 * HTB + aoff + m * 2048 + k * 1024); } while (0)
#define PGH_MMA(fb) do { __builtin_amdgcn_s_setprio(1); _Pragma("unroll") for (int m = 0; m < 4; ++m) _Pragma("unroll") for (int n = 0; n < 2; ++n) _Pragma("unroll") for (int k = 0; k < 2; ++k) { \
            acc[0][0][m][n] = __builtin_amdgcn_mfma_f32_16x16x32_bf16(B0[fb][n][k], At[fb][m][k], acc[0][0][m][n], 0, 0, 0); \
            acc[0][1][m][n] = __builtin_amdgcn_mfma_f32_16x16x32_bf16(B1[fb][n][k], At[fb][m][k], acc[0][1][m][n], 0, 0, 0); } __builtin_amdgcn_s_setprio(0); } while (0)
#define PGH_STAGE3(so, kt) do { const size_t ko_ = (size_t)(((kt) < nt) ? (kt) : ((kt) - nt)) * kstep; \
        PGH_STAGE((so), cB + ko_, voffB); PGH_STAGE((so) + HTB, cB + hstep + ko_, voffB); PGH_STAGE((so) + 2 * HTB, cA + ko_, voffA); } while (0)
    PGH_STAGE3(0 * 3 * HTB, 0); PGH_STAGE3(1 * 3 * HTB, 1); PGH_STAGE3(2 * 3 * HTB, 2);
    asm volatile("s_waitcnt vmcnt(12)" ::: "memory"); __builtin_amdgcn_s_barrier();
    PGH_READ(0, 0);
    asm volatile("s_waitcnt lgkmcnt(0)" ::: "memory"); asm volatile("s_waitcnt vmcnt(6)" ::: "memory"); __builtin_amdgcn_s_barrier();
    int s = 0;
    for (int t = 0; t < nt; t += 2) {
        {   const int s1 = (s == 2) ? 0 : s + 1;
            PGH_READ(1, s1 * 3 * HTB); PGH_STAGE3(s * 3 * HTB, t + 3);
            PGH_MMA(0);
            asm volatile("s_waitcnt lgkmcnt(0)" ::: "memory"); asm volatile("s_waitcnt vmcnt(6)" ::: "memory"); __builtin_amdgcn_s_barrier(); __builtin_amdgcn_sched_barrier(0);
            s = s1; }
        {   const int s1 = (s == 2) ? 0 : s + 1;
            PGH_READ(0, s1 * 3 * HTB); PGH_STAGE3(s * 3 * HTB, t + 4);
            PGH_MMA(1);
            asm volatile("s_waitcnt lgkmcnt(0)" ::: "memory"); asm volatile("s_waitcnt vmcnt(6)" ::: "memory"); __builtin_amdgcn_s_barrier(); __builtin_amdgcn_sched_barrier(0);
            s = s1; }
    }
#undef PGH_READ
#undef PGH_MMA
#undef PGH_STAGE3
    asm volatile("s_waitcnt vmcnt(0)" ::: "memory"); __builtin_amdgcn_s_barrier();
    { int lz2 = 0; asm volatile("" : "+v"(lz2)); const int le = (int)__builtin_amdgcn_mbcnt_hi(~0u, __builtin_amdgcn_mbcnt_lo(~0u, (unsigned)lz2)); E(acc, u, wr, wc, le & 15, le >> 4); }
#undef PGH_STAGE
}
}
#define GAS __attribute__((address_space(1)))
#define LAS __attribute__((address_space(3)))
typedef unsigned short bf16;
typedef unsigned v4u __attribute__((ext_vector_type(4)));
typedef unsigned v2u __attribute__((ext_vector_type(2)));
typedef float f32x4 __attribute__((ext_vector_type(4)));
typedef short bf16x8 __attribute__((ext_vector_type(8)));
#define LDS_WAIT() asm volatile("s_waitcnt lgkmcnt(0)" ::: "memory")
__device__ __forceinline__ unsigned f2bf(float f) { unsigned u = __builtin_bit_cast(unsigned, f); return (u + 0x7fffu + ((u >> 16) & 1u)) >> 16; }
__device__ __forceinline__ unsigned pk2(float lo, float hi) { return f2bf(lo) | (f2bf(hi) << 16); }
__device__ __forceinline__ void st16_wt(void* p, v4u v) { *(v4u*)p = v; }
__device__ __forceinline__ void st8_wt(void* p, v2u v) { *(v2u*)p = v; }
__device__ __forceinline__ void st16f_wt(void* p, f32x4 v) { *(f32x4*)p = v; }
#define XB_TMO      128
#define XB_XCNT(j)  (256  + 64 * (j))
#define XB_XSUB(j)  (1280 + 64 * (j))
#define XB_XGEN(j)  (2304 + 64 * (j))
#define XB_TOP      3328
#define XB_TOPGEN   3392
#define XCD_BAR_WORDS 3456
#define XB_SPIN_CAP (1u << 18)

__device__ __forceinline__ unsigned xb_ld(unsigned* p)              { return __hip_atomic_load(p, __ATOMIC_RELAXED, __HIP_MEMORY_SCOPE_AGENT); }
__device__ __forceinline__ unsigned xb_add(unsigned* p, unsigned v) { return __hip_atomic_fetch_add(p, v, __ATOMIC_RELAXED, __HIP_MEMORY_SCOPE_AGENT); }
__device__ __forceinline__ unsigned xb_xcc_id() { return (unsigned)__builtin_amdgcn_s_getreg((3 << 11) | 20) & 0xFu; }
#define XB_SPIN(cond, bar) do { unsigned _sp = 0; while (cond) { __builtin_amdgcn_s_sleep(1); \
    if ((++_sp & 255u) == 0u) { if (xb_ld(&(bar)[XB_TMO])) break; if (_sp > XB_SPIN_CAP) { atomicAdd(&(bar)[XB_TMO], 1u); break; } } } } while (0)

struct XcdBarrier {
    unsigned* bar; unsigned x;
    volatile LAS unsigned* st;
};

__device__ __forceinline__ XcdBarrier xcd_barrier_post(unsigned* bar, volatile LAS unsigned* st) {
    XcdBarrier b; b.bar = bar; b.x = xb_xcc_id(); b.st = st;
    if (threadIdx.x == 0) (void)xb_add(&bar[XB_XCNT(b.x)], 1u);
    return b;
}
__device__ __forceinline__ void xcd_barrier_complete(unsigned* bar, unsigned x, unsigned& nloc, unsigned& nx) {
    const unsigned G = gridDim.x * gridDim.y * gridDim.z;
    unsigned sum, cnt, mine, sp = 0u;
    for (;;) {
        sum = 0u; cnt = 0u; mine = 0u;
#pragma unroll
        for (unsigned j = 0; j < 16; ++j) { const unsigned c = xb_ld(&bar[XB_XCNT(j)]); sum += c; cnt += (c > 0u) ? 1u : 0u; mine = (j == x) ? c : mine; }
        if (sum == G) break;
        __builtin_amdgcn_s_sleep(1);
        if ((++sp & 255u) == 0u) { if (xb_ld(&bar[XB_TMO])) break; if (sp > XB_SPIN_CAP) { atomicAdd(&bar[XB_TMO], 1u); break; } }
    }
    nloc = mine > 0u ? mine : 1u; nx = cnt > 0u ? cnt : 1u;
}

__device__ __forceinline__ void xcd_barrier(const XcdBarrier& b) {
    asm volatile("s_waitcnt vmcnt(0)" ::: "memory");
    __syncthreads();
    if (threadIdx.x == 0) {
        unsigned* bar = b.bar;
        __builtin_amdgcn_s_waitcnt(0);
        unsigned nloc = b.st[0], nx = b.st[1];
        if (nloc == 0u) { xcd_barrier_complete(bar, b.x, nloc, nx); b.st[0] = nloc; b.st[1] = nx; }
        const unsigned old = xb_add(&bar[XB_XSUB(b.x)], 1u);
        const unsigned gen = old / nloc;
        if (old + 1u == (gen + 1u) * nloc) {
            __builtin_amdgcn_fence(__ATOMIC_RELEASE, "agent");
            asm volatile("s_waitcnt vmcnt(0)" ::: "memory");
            const unsigned og = xb_add(&bar[XB_TOP], 1u);
            const unsigned tg = og / nx;
            if (og + 1u == (tg + 1u) * nx) xb_add(&bar[XB_TOPGEN], 1u);
            else XB_SPIN(xb_ld(&bar[XB_TOPGEN]) == tg, bar);
            __builtin_amdgcn_fence(__ATOMIC_ACQUIRE, "agent");
            xb_add(&bar[XB_XGEN(b.x)], 1u);
            asm volatile("s_waitcnt vmcnt(0)" ::: "memory");
        } else {
            XB_SPIN(xb_ld(&bar[XB_XGEN(b.x)]) == gen, bar);
            __builtin_amdgcn_fence(__ATOMIC_ACQUIRE, "agent");
            asm volatile("s_waitcnt vmcnt(0)" ::: "memory");
        }
    }
    __syncthreads();
}


constexpr int T = 16384, D = 1024, FF = 2816, NIN = 5632, NAB = 2560, MODW = 9216;
constexpr float EPS = 1e-6f;
constexpr size_t MiB = 1u << 20;
constexpr size_t WS_CTL = 0, CTL_ZERO_BYTES = 64 * 1024;
constexpr int CW_BAR = 1024;
constexpr size_t WS_MOD = 1 * MiB;
constexpr size_t WS_GK = 2 * MiB;
constexpr size_t WS_GATE = 2 * MiB + 256 * 1024;
constexpr size_t WS_RGK = 2 * MiB + 512 * 1024;
constexpr size_t WS_BIAS = 3 * MiB;
constexpr size_t BIAS_STRIDE_F = 65536;
constexpr size_t WS_ROWSS = 5 * MiB;
constexpr size_t WS_WS = 6 * MiB;
constexpr size_t WS_WGT = 6 * MiB + 512 * 1024;
constexpr size_t WS_HALOP = 7 * MiB;
constexpr size_t WS_VSTAT = 7 * MiB + 512 * 1024;
constexpr int CW_XCC = 512, CW_BAD = 448;
constexpr int CW_GRP = 8192;
constexpr size_t WS_WIN = 8 * MiB;
constexpr size_t WS_WOUT = 52 * MiB;
constexpr size_t WS_ABIN = 74 * MiB;
constexpr size_t WS_ABOUT = 79 * MiB;
constexpr size_t WS_XB = 82 * MiB;
constexpr size_t WS_YMIX = 114 * MiB;
constexpr size_t WS_ACT = 146 * MiB;
constexpr size_t WS_X2 = 236 * MiB;
constexpr size_t WS_END = 300 * MiB;

constexpr int RING_BYTES = 131072, LDSCTL_OFF = RING_BYTES, MISC_OFF = LDSCTL_OFF + 320, LDS_BYTES = 147456;

__device__ __forceinline__ float wave_sum(float v) {
#pragma unroll
    for (int o = 1; o < 64; o <<= 1) v += __shfl_xor(v, o);
    return v;
}
__device__ __forceinline__ float bflo(unsigned u) { return __uint_as_float(u << 16); }
__device__ __forceinline__ float bfhi(unsigned u) { return __uint_as_float(u & 0xffff0000u); }
__device__ __forceinline__ float silu_f(float x) { return x * __builtin_amdgcn_rcpf(1.f + __builtin_amdgcn_exp2f(-1.44269504f * x)); }
__device__ __forceinline__ float gelu_tanh_f(float x) { const float u = 0.7978845608f * (x + 0.044715f * x * x * x); return x * __builtin_amdgcn_rcpf(1.f + __builtin_amdgcn_exp2f(-2.88539008f * u)); }
__device__ __forceinline__ f32x4 mfma16(bf16x8 a, bf16x8 b, f32x4 c) { return __builtin_amdgcn_mfma_f32_16x16x32_bf16(a, b, c, 0, 0, 0); }

#ifndef PROBE_SWIGLU2
#define PROBE_SWIGLU2 0
#endif
#ifndef PROBE_RESID2
#define PROBE_RESID2 0
#endif
struct EpiSwiglu {
    static constexpr bool PERM = true, AFTER_DRAIN = false, TWICE = PROBE_SWIGLU2; static constexpr int NST = TWICE ? 0 : 8;
    bf16* O; const float* rowss; const float* bias;
    __device__ __forceinline__ void again(const f32x4 (&acc)[2][2][4][2], const pg8::Unit& u, int wr, int wc, int fr, int fq) const { (*this)(acc, u, wr, wc, fr, fq); }
    __device__ __forceinline__ void operator()(const f32x4 (&acc)[2][2][4][2], const pg8::Unit& u, int wr, int wc, int fr, int fq) const {
        const int b = u.pm >> 3;
        const float* bp = bias + b * NIN + u.pn * 256 + wc * 32 + 8 * fq;
        f32x4 bg[2], bu[2], bgl[2];
#pragma unroll
        for (int n = 0; n < 2; ++n) { bg[n] = *(const f32x4*)(bp + 4 * n); bu[n] = *(const f32x4*)(bp + 128 + 4 * n); bgl[n] = bg[n] * -1.44269504f; }
        const int hid0 = u.pn * 128 + wc * 32 + 8 * fq;
        float rsv[8];
#pragma unroll
        for (int q = 0; q < 8; ++q) rsv[q] = (u.half && q >= 4) ? 1.f : rowss[u.pm * 256 + ((q >> 2) + u.hsel) * 128 + wr * 64 + (q & 3) * 16 + fr];
        asm volatile("" ::: "memory");
#pragma unroll
        for (int ai = 0; ai < 2; ++ai)
#pragma unroll
            for (int m = 0; m < 4; ++m) {
                if (u.half && ai == 1) continue;
                const int row = u.pm * 256 + (ai + u.hsel) * 128 + wr * 64 + m * 16 + fr;
                const float rs = rsqrtf(rsv[ai * 4 + m] * (1.f / 1024.f) + EPS);
                v4u w; const float k1 = -1.44269504f * rs;
#pragma unroll
                for (int n = 0; n < 2; ++n) {
                    const f32x4 g = acc[ai][0][m][n] * rs + bg[n], t = acc[ai][0][m][n] * k1 + bgl[n], uu = acc[ai][1][m][n] * rs + bu[n];
                    f32x4 e; e[0] = __builtin_amdgcn_exp2f(t[0]); e[1] = __builtin_amdgcn_exp2f(t[1]); e[2] = __builtin_amdgcn_exp2f(t[2]); e[3] = __builtin_amdgcn_exp2f(t[3]);
                    e = e + 1.f;
                    f32x4 r; r[0] = __builtin_amdgcn_rcpf(e[0]); r[1] = __builtin_amdgcn_rcpf(e[1]); r[2] = __builtin_amdgcn_rcpf(e[2]); r[3] = __builtin_amdgcn_rcpf(e[3]);
                    const f32x4 a = (g * uu) * r;
                    if (n == 0) { w.x = pg8::cvt_pk_bf16(a[0], a[1]); w.y = pg8::cvt_pk_bf16(a[2], a[3]); } else { w.z = pg8::cvt_pk_bf16(a[0], a[1]); w.w = pg8::cvt_pk_bf16(a[2], a[3]); }
                }
                st16_wt(O + (size_t)row * FF + hid0, w);
            }
    }
};
struct EpiProj {
    static constexpr bool PERM = true, AFTER_DRAIN = false, TWICE = false; static constexpr int NST = 16;
    bf16* O; const float* rowss; const float* bias; bf16* halo; float* vstat;
    __device__ __forceinline__ void operator()(const f32x4 (&acc)[2][2][4][2], const pg8::Unit& u, int wr, int wc, int fr, int fq) const {
        const int b = u.pm >> 3; const int col0 = u.pn * 256 + wc * 32 + 8 * fq;
        const float* bp = bias + b * NAB + col0;
        f32x4 bv[2][2];
#pragma unroll
        for (int bj = 0; bj < 2; ++bj)
#pragma unroll
            for (int n = 0; n < 2; ++n) bv[bj][n] = *(const f32x4*)(bp + 128 * bj + 4 * n);
        const bool act = u.pn < 4;
        float rsv[8];
#pragma unroll
        for (int q = 0; q < 8; ++q) rsv[q] = (u.half && q >= 4) ? 1.f : rowss[u.pm * 256 + ((q >> 2) + u.hsel) * 128 + wr * 64 + (q & 3) * 16 + fr];
        asm volatile("" ::: "memory");
#pragma unroll
        for (int ai = 0; ai < 2; ++ai)
#pragma unroll
            for (int m = 0; m < 4; ++m) {
                if (u.half && ai == 1) continue;
                const int row = u.pm * 256 + (ai + u.hsel) * 128 + wr * 64 + m * 16 + fr;
                const float rs = rsqrtf(rsv[ai * 4 + m] * (1.f / 1024.f) + EPS);
                float s1 = 0.f, s2 = 0.f;
#pragma unroll
                for (int bj = 0; bj < 2; ++bj) {
                    f32x4 v0 = acc[ai][bj][m][0] * rs + bv[bj][0], v1 = acc[ai][bj][m][1] * rs + bv[bj][1];
                    if (act) {
#pragma unroll
                        for (int j = 0; j < 4; ++j) { v0[j] = gelu_tanh_f(v0[j]); v1[j] = gelu_tanh_f(v1[j]); }
                        s1 += ((v0[0] + v0[1]) + (v0[2] + v0[3])) + ((v1[0] + v1[1]) + (v1[2] + v1[3]));
                        s2 += ((v0[0] * v0[0] + v0[1] * v0[1]) + (v0[2] * v0[2] + v0[3] * v0[3])) + ((v1[0] * v1[0] + v1[1] * v1[1]) + (v1[2] * v1[2] + v1[3] * v1[3])); }
                    v4u w; w.x = pg8::cvt_pk_bf16(v0[0], v0[1]); w.y = pg8::cvt_pk_bf16(v0[2], v0[3]); w.z = pg8::cvt_pk_bf16(v1[0], v1[1]); w.w = pg8::cvt_pk_bf16(v1[2], v1[3]);
                    st16_wt(O + (size_t)row * NAB + col0 + 128 * bj, w);
                    if (ai + u.hsel == 1 && m == 3) { if (wr == 1 && fr >= 14 && u.pn >= 6) *(v4u*)(halo + (size_t)(u.pm * 2 + (fr - 14)) * 1024 + (col0 + 128 * bj - 1536)) = w; }
                }
                if (u.pn == 2 || u.pn == 3) {
                    s1 += __shfl_xor(s1, 16); s1 += __shfl_xor(s1, 32); s2 += __shfl_xor(s2, 16); s2 += __shfl_xor(s2, 32);
                    if (fq == 0) { (void)__hip_atomic_fetch_add(vstat + 2 * row, s1, __ATOMIC_RELAXED, __HIP_MEMORY_SCOPE_AGENT); (void)__hip_atomic_fetch_add(vstat + 2 * row + 1, s2, __ATOMIC_RELAXED, __HIP_MEMORY_SCOPE_AGENT); }
                }
            }
    }
};
struct EpiNull {
    static constexpr bool PERM = true, AFTER_DRAIN = false, TWICE = false; static constexpr int NST = 0;
    __device__ __forceinline__ void operator()(const f32x4 (&acc)[2][2][4][2], const pg8::Unit& u, int wr, int wc, int fr, int fq) const {
#pragma unroll
        for (int ai = 0; ai < 2; ++ai)
#pragma unroll
            for (int bj = 0; bj < 2; ++bj)
#pragma unroll
                for (int m = 0; m < 4; ++m)
#pragma unroll
                    for (int n = 0; n < 2; ++n) asm volatile("" :: "v"(acc[ai][bj][m][n]));
    }
};
struct EpiResid {
    static constexpr bool PERM = true, AFTER_DRAIN = false, TWICE = false; static constexpr int NST = 0;
    const bf16* xin_b; const float* rgk_old; const float* gate; float* rowss_next; const float* gk_next; bf16* xb; float* xout;
    __device__ __forceinline__ void operator()(const f32x4 (&acc)[2][2][4][2], const pg8::Unit& u, int wr, int wc, int fr, int fq) const {
        const int b = u.pm >> 3; const int col0 = u.pn * 256 + wc * 32 + 8 * fq;
        f32x4 gt[2][2], gk[2][2], rg[2][2];
#pragma unroll
        for (int bj = 0; bj < 2; ++bj)
#pragma unroll
            for (int n = 0; n < 2; ++n) {
                gt[bj][n] = *(const f32x4*)(gate + b * 1024 + col0 + 128 * bj + 4 * n);
                gk[bj][n] = gk_next ? *(const f32x4*)(gk_next + b * 1024 + col0 + 128 * bj + 4 * n) : (f32x4){0.f, 0.f, 0.f, 0.f};
                rg[bj][n] = *(const f32x4*)(rgk_old + b * 1024 + col0 + 128 * bj + 4 * n);
            }
        v4u xq[8][2];
#define EPI_LOADG(gq_) do { const int row_ = u.pm * 256 + ((gq_) >> 2) * 128 + wr * 64 + ((gq_) & 3) * 16 + fr; const bf16* p_ = xin_b + (size_t)row_ * D + col0; \
            xq[gq_][0] = *(const v4u*)(p_); xq[gq_][1] = *(const v4u*)(p_ + 128); } while (0)
        EPI_LOADG(0); EPI_LOADG(1); EPI_LOADG(2);
#pragma unroll
        for (int gq = 0; gq < 8; ++gq) {
            if (gq + 3 < 8) EPI_LOADG(gq + 3);
            asm volatile("" ::: "memory");
            const int ai = gq >> 2, m = gq & 3;
            const int row = u.pm * 256 + ai * 128 + wr * 64 + m * 16 + fr;
            float ss = 0.f;
#pragma unroll
            for (int bj = 0; bj < 2; ++bj) {
                const size_t off = (size_t)row * D + col0 + 128 * bj;
                const v4u rw = xq[gq][bj];
                f32x4 x0 = (f32x4){bflo(rw.x), bfhi(rw.x), bflo(rw.y), bfhi(rw.y)} * rg[bj][0], x1 = (f32x4){bflo(rw.z), bfhi(rw.z), bflo(rw.w), bfhi(rw.w)} * rg[bj][1];
                x0 += gt[bj][0] * acc[ai][bj][m][0]; x1 += gt[bj][1] * acc[ai][bj][m][1];
                ss += (x0[0] * x0[0] + x0[1] * x0[1]) + (x0[2] * x0[2] + x0[3] * x0[3]) + (x1[0] * x1[0] + x1[1] * x1[1]) + (x1[2] * x1[2] + x1[3] * x1[3]);
                if (gk_next) { const f32x4 y0 = x0 * gk[bj][0], y1 = x1 * gk[bj][1];
                    v4u w; w.x = pg8::cvt_pk_bf16(y0[0], y0[1]); w.y = pg8::cvt_pk_bf16(y0[2], y0[3]); w.z = pg8::cvt_pk_bf16(y1[0], y1[1]); w.w = pg8::cvt_pk_bf16(y1[2], y1[3]);
                    st16_wt(xb + off, w); }
                else { st16f_wt(xout + off, x0); st16f_wt(xout + off + 4, x1); }
            }
            ss += __shfl_xor(ss, 16); ss += __shfl_xor(ss, 32);
            if (fq == 0) (void)__hip_atomic_fetch_add(rowss_next + row, ss, __ATOMIC_RELAXED, __HIP_MEMORY_SCOPE_AGENT);
            asm volatile("" ::: "memory");
        }
#undef EPI_LOADG
    }
};

__device__ __forceinline__ void group_barrier(unsigned* cnt, unsigned& k, int same_xcc);
struct EpiResidFinal {
    static constexpr bool PERM = true, AFTER_DRAIN = false, TWICE = false; static constexpr int NST = 0;
    const bf16* xin_b; const float* rgk_old; const float* gate; float* rowss; const float* final_g; float* out; unsigned* gcnt; unsigned& gk; int same_xcc;
    __device__ __forceinline__ void operator()(f32x4 (&acc)[2][2][4][2], const pg8::Unit& u, int wr, int wc, int fr, int fq) const {
        const int b = u.pm >> 3; const int col0 = u.pn * 256 + wc * 32 + 8 * fq;
        {
            f32x4 gt[2][2], rg[2][2];
#pragma unroll
            for (int bj = 0; bj < 2; ++bj)
#pragma unroll
                for (int n = 0; n < 2; ++n) { gt[bj][n] = *(const f32x4*)(gate + b * 1024 + col0 + 128 * bj + 4 * n); rg[bj][n] = *(const f32x4*)(rgk_old + b * 1024 + col0 + 128 * bj + 4 * n); }
            v4u xq[8][2];
#define EPI_LOADG(gq_) do { const int row_ = u.pm * 256 + ((gq_) >> 2) * 128 + wr * 64 + ((gq_) & 3) * 16 + fr; const bf16* p_ = xin_b + (size_t)row_ * D + col0; \
            xq[gq_][0] = *(const v4u*)(p_); xq[gq_][1] = *(const v4u*)(p_ + 128); } while (0)
            EPI_LOADG(0); EPI_LOADG(1); EPI_LOADG(2);
#pragma unroll
            for (int gq = 0; gq < 8; ++gq) {
                if (gq + 3 < 8) EPI_LOADG(gq + 3);
                asm volatile("" ::: "memory");
                const int ai = gq >> 2, m = gq & 3; const int row = u.pm * 256 + ai * 128 + wr * 64 + m * 16 + fr;
                float ss = 0.f;
#pragma unroll
                for (int bj = 0; bj < 2; ++bj) {
                    const v4u rw = xq[gq][bj];
                    f32x4 x0 = (f32x4){bflo(rw.x), bfhi(rw.x), bflo(rw.y), bfhi(rw.y)} * rg[bj][0], x1 = (f32x4){bflo(rw.z), bfhi(rw.z), bflo(rw.w), bfhi(rw.w)} * rg[bj][1];
                    x0 += gt[bj][0] * acc[ai][bj][m][0]; x1 += gt[bj][1] * acc[ai][bj][m][1];
                    acc[ai][bj][m][0] = x0; acc[ai][bj][m][1] = x1;
                    ss += (x0[0] * x0[0] + x0[1] * x0[1]) + (x0[2] * x0[2] + x0[3] * x0[3]) + (x1[0] * x1[0] + x1[1] * x1[1]) + (x1[2] * x1[2] + x1[3] * x1[3]);
                }
                ss += __shfl_xor(ss, 16); ss += __shfl_xor(ss, 32);
                if (fq == 0) (void)__hip_atomic_fetch_add(rowss + row, ss, __ATOMIC_RELAXED, __HIP_MEMORY_SCOPE_AGENT);
            }
#undef EPI_LOADG
        }
        group_barrier(gcnt, gk, same_xcc);
        f32x4 fg[2][2]; float rsv[8];
#pragma unroll
        for (int bj = 0; bj < 2; ++bj)
#pragma unroll
            for (int n = 0; n < 2; ++n) fg[bj][n] = *(const f32x4*)(final_g + col0 + 128 * bj + 4 * n);
#pragma unroll
        for (int q = 0; q < 8; ++q) rsv[q] = __hip_atomic_load(rowss + u.pm * 256 + (q >> 2) * 128 + wr * 64 + (q & 3) * 16 + fr, __ATOMIC_RELAXED, __HIP_MEMORY_SCOPE_AGENT);
#pragma unroll
        for (int gq = 0; gq < 8; ++gq) {
            const int ai = gq >> 2, m = gq & 3; const int row = u.pm * 256 + ai * 128 + wr * 64 + m * 16 + fr;
            const float rs = rsqrtf(rsv[gq] * (1.f / 1024.f) + EPS);
#pragma unroll
            for (int bj = 0; bj < 2; ++bj) {
                const size_t off = (size_t)row * D + col0 + 128 * bj;
                *(f32x4*)(out + off) = acc[ai][bj][m][0] * rs * fg[bj][0]; *(f32x4*)(out + off + 4) = acc[ai][bj][m][1] * rs * fg[bj][1];
            }
        }
    }
};

__device__ __forceinline__ void transpose_item(const float* W, int K, int N, bf16* WT, int mode, LAS float* scr, int item, int lane) {
    const int nblk = N / 32, kb = item / nblk, nb = item % nblk, k0 = 64 * kb, n0 = 32 * nb;
    int drow0 = n0;
    if (mode == 1) { const int j = n0 < FF ? n0 : n0 - FF; drow0 = (j >> 7) * 256 + (j & 127) + (n0 < FF ? 0 : 128); }
#pragma unroll 8
    for (int i = 0; i < 32; ++i) { const int kk = 2 * i + (lane >> 5); scr[kk * 33 + (lane & 31)] = W[(size_t)(k0 + kk) * N + n0 + (lane & 31)]; }
    LDS_WAIT(); asm volatile("" ::: "memory");
    const int c = lane & 7;
#pragma unroll
    for (int j = 0; j < 4; ++j) { const int n = (lane >> 3) + 8 * j; const LAS float* s = scr + (8 * c) * 33 + n;
        v4u o; o.x = pk2(s[0 * 33], s[1 * 33]); o.y = pk2(s[2 * 33], s[3 * 33]); o.z = pk2(s[4 * 33], s[5 * 33]); o.w = pk2(s[6 * 33], s[7 * 33]);
        *(v4u*)(WT + (size_t)(drow0 + n) * K + k0 + 8 * c) = o; }
    LDS_WAIT(); asm volatile("" ::: "memory");
}
__device__ __forceinline__ void mod_task(const float* c, const float* w_mod, const float* b_mod, float* MOD, LAS float* fl, int task, int tid, int wave, int lane) {
    const int l = task / 72, cgp = task % 72;
    for (int i = tid; i < 8192; i += 512) { const float v = c[i]; fl[i] = v / (1.f + __expf(-v)); }
    __syncthreads();
    const int col = cgp * 128 + lane * 2;
    const float* wp = w_mod + (size_t)l * D * MODW + (size_t)(wave * 128) * MODW + col;
    float acc[8][2];
#pragma unroll
    for (int b = 0; b < 8; ++b) { acc[b][0] = 0.f; acc[b][1] = 0.f; }
#pragma unroll 16
    for (int k = 0; k < 128; ++k) {
        const float2 w = *(const float2*)(wp + (size_t)k * MODW);
#pragma unroll
        for (int b = 0; b < 8; ++b) { const float cv = fl[b * 1024 + wave * 128 + k]; acc[b][0] += cv * w.x; acc[b][1] += cv * w.y; }
    }
#pragma unroll
    for (int b = 0; b < 8; ++b) { fl[8192 + (wave * 8 + b) * 128 + lane * 2] = acc[b][0]; fl[8192 + (wave * 8 + b) * 128 + lane * 2 + 1] = acc[b][1]; }
    __syncthreads();
    for (int o = tid; o < 1024; o += 512) { const int b = o >> 7, cc = o & 127; float s = 0.f;
#pragma unroll
        for (int w = 0; w < 8; ++w) s += fl[8192 + (w * 8 + b) * 128 + cc];
        MOD[(size_t)(l * 8 + b) * MODW + cgp * 128 + cc] = s + b_mod[l * MODW + cgp * 128 + cc]; }
    __syncthreads();
}
__device__ __forceinline__ bf16x8 pack8(const float (&v)[8]) {
    v4u o; o.x = pk2(v[0], v[1]); o.y = pk2(v[2], v[3]); o.z = pk2(v[4], v[5]); o.w = pk2(v[6], v[7]);
    return __builtin_bit_cast(bf16x8, o);
}

__device__ __forceinline__ void mid_phase(const bf16* PROJ, bf16* YMIX, const bf16* WST, const float* norm_v, const float* b_s, const float* conv_w, const bf16* HALOP, const float* VSTAT,
                                          LAS unsigned char* lds, int pm, int g, int wave_in, int lane_in) {
    LAS bf16* vT = (LAS bf16*)lds; constexpr int VS = 136;
#pragma clang loop unroll(disable)
    for (int q = 0; q < 2; ++q) {
        int lane = lane_in; asm volatile("" : "+v"(lane));
        int wave = wave_in; asm volatile("" : "+s"(wave));
        const int fr = lane & 15, fq = lane >> 4;
        const int cidx = 2 * pm + (g >> 1), h = 2 * (g & 1) + q, tok0 = cidx * 128;
        {
            const int hl = lane & 15, rsub = lane >> 4;
            float nv[8];
#pragma unroll
            for (int j = 0; j < 8; ++j) nv[j] = norm_v[128 * h + 8 * hl + j];
            v4u rawv[4]; float st1[4], st2[4];
#pragma unroll
            for (int it = 0; it < 4; ++it) { const int t = tok0 + 16 * wave + 4 * it + rsub; rawv[it] = *(const v4u*)(PROJ + (size_t)t * NAB + 512 + 128 * h + 8 * hl); st1[it] = VSTAT[2 * t]; st2[it] = VSTAT[2 * t + 1]; }
#pragma unroll
            for (int it = 0; it < 4; ++it) {
                const int s = 16 * wave + 4 * it + rsub; const v4u raw = rawv[it];
                float f[8]; f[0] = bflo(raw.x); f[1] = bfhi(raw.x); f[2] = bflo(raw.y); f[3] = bfhi(raw.y); f[4] = bflo(raw.z); f[5] = bfhi(raw.z); f[6] = bflo(raw.w); f[7] = bfhi(raw.w);
                const float mean = st1[it] * (1.f / 512.f), var = fmaxf(st2[it] * (1.f / 512.f) - mean * mean, 0.f), rs = rsqrtf(var + EPS);
#pragma unroll
                for (int j = 0; j < 8; ++j) vT[(8 * hl + j) * VS + s] = (bf16)f2bf((f[j] - mean) * rs * nv[j]);
            }
        }
        __syncthreads();
        f32x4 acc[8];
#pragma unroll
        for (int d = 0; d < 8; ++d) acc[d] = (f32x4){0.f, 0.f, 0.f, 0.f};
        const int t0 = 16 * wave, kkmax = (t0 + 15) >> 5;
        for (int kk = 0; kk <= kkmax; ++kk) {
            const bf16x8 wf = *(const bf16x8*)(WST + (size_t)(h * 128 + t0 + fr) * 128 + 32 * kk + 8 * fq);
#pragma unroll
            for (int d = 0; d < 8; ++d) { const bf16x8 vf = *(const LAS bf16x8*)(vT + (16 * d + fr) * VS + 32 * kk + 8 * fq); acc[d] = mfma16(vf, wf, acc[d]); }
        }
        {
            const int t = tok0 + t0 + fr; const float zb = b_s[h * 128 + t0 + fr];
#pragma unroll
            for (int d = 0; d < 8; ++d) {
                const int col = 128 * h + 16 * d + 4 * fq;
                const v2u gu = *(const v2u*)(PROJ + (size_t)t * NAB + col);
                const float y0 = bflo(gu.x) * (acc[d][0] + zb), y1 = bfhi(gu.x) * (acc[d][1] + zb), y2 = bflo(gu.y) * (acc[d][2] + zb), y3 = bfhi(gu.y) * (acc[d][3] + zb);
                v2u w; w.x = pk2(y0, y1); w.y = pk2(y2, y3);
                st8_wt(YMIX + (size_t)t * D + col, w);
            }
        }
        {
            const int tf = tok0 + 32 * h + 4 * wave; const bool halo = (tf & 2047) != 0; const int c = 8 * lane;
            float w0[8], w1[8], w2[8], pm2[8], pm1[8];
#pragma unroll
            for (int j = 0; j < 8; ++j) { w0[j] = conv_w[c + j]; w1[j] = conv_w[512 + c + j]; w2[j] = conv_w[1024 + c + j]; pm2[j] = 0.f; pm1[j] = 0.f; }
            if (halo) {
                const bool nb = (tf & 255) == 0;
                const bf16* p2 = nb ? HALOP + (size_t)((pm - 1) * 2 + 0) * 1024 + c - 1536 : PROJ + (size_t)(tf - 2) * NAB + c;
                const bf16* p1 = nb ? HALOP + (size_t)((pm - 1) * 2 + 1) * 1024 + c - 1536 : PROJ + (size_t)(tf - 1) * NAB + c;
                const v4u a2 = *(const v4u*)(p2 + 1536), b2 = *(const v4u*)(p2 + 2048), a1 = *(const v4u*)(p1 + 1536), b1 = *(const v4u*)(p1 + 2048);
                pm2[0] = bflo(a2.x) * bflo(b2.x); pm2[1] = bfhi(a2.x) * bfhi(b2.x); pm2[2] = bflo(a2.y) * bflo(b2.y); pm2[3] = bfhi(a2.y) * bfhi(b2.y);
                pm2[4] = bflo(a2.z) * bflo(b2.z); pm2[5] = bfhi(a2.z) * bfhi(b2.z); pm2[6] = bflo(a2.w) * bflo(b2.w); pm2[7] = bfhi(a2.w) * bfhi(b2.w);
                pm1[0] = bflo(a1.x) * bflo(b1.x); pm1[1] = bfhi(a1.x) * bfhi(b1.x); pm1[2] = bflo(a1.y) * bflo(b1.y); pm1[3] = bfhi(a1.y) * bfhi(b1.y);
                pm1[4] = bflo(a1.z) * bflo(b1.z); pm1[5] = bfhi(a1.z) * bfhi(b1.z); pm1[6] = bflo(a1.w) * bflo(b1.w); pm1[7] = bfhi(a1.w) * bfhi(b1.w);
            }
#pragma unroll
            for (int r = 0; r < 4; ++r) {
                const bf16* pr = PROJ + (size_t)(tf + r) * NAB + c;
                const v4u g = *(const v4u*)(pr + 1024), a = *(const v4u*)(pr + 1536), x = *(const v4u*)(pr + 2048);
                float cur[8], bgv[8], y[8];
                cur[0] = bflo(a.x) * bflo(x.x); cur[1] = bfhi(a.x) * bfhi(x.x); cur[2] = bflo(a.y) * bflo(x.y); cur[3] = bfhi(a.y) * bfhi(x.y);
                cur[4] = bflo(a.z) * bflo(x.z); cur[5] = bfhi(a.z) * bfhi(x.z); cur[6] = bflo(a.w) * bflo(x.w); cur[7] = bfhi(a.w) * bfhi(x.w);
                bgv[0] = bflo(g.x); bgv[1] = bfhi(g.x); bgv[2] = bflo(g.y); bgv[3] = bfhi(g.y); bgv[4] = bflo(g.z); bgv[5] = bfhi(g.z); bgv[6] = bflo(g.w); bgv[7] = bfhi(g.w);
#pragma unroll
                for (int j = 0; j < 8; ++j) { y[j] = bgv[j] * (w0[j] * pm2[j] + w1[j] * pm1[j] + w2[j] * cur[j]); pm2[j] = pm1[j]; pm1[j] = cur[j]; }
                v4u o; o.x = pk2(y[0], y[1]); o.y = pk2(y[2], y[3]); o.z = pk2(y[4], y[5]); o.w = pk2(y[6], y[7]);
                st16_wt(YMIX + (size_t)(tf + r) * D + 512 + c, o);
            }
        }
        __syncthreads();
    }
}

constexpr int PS = 264;
template <int W> __device__ __forceinline__ void pool_build(const bf16* XBI, const float* rowss, const float* shp, LAS bf16* P, int tile0, int g, int wave, int lane) {
    const int c = 256 * g + 4 * lane, trow0 = tile0 + 16 * wave, tpos0 = trow0 & 2047;
    const f32x4 sh = *(const f32x4*)(shp + c);
    f32x4 ring[W];
#pragma unroll
    for (int r = -(W - 1); r < 16; ++r) {
        const int t = trow0 + r; const bool valid = (tpos0 + r) >= 0;
        f32x4 hv = (f32x4){0.f, 0.f, 0.f, 0.f};
        if (valid) { const float rs = rsqrtf(rowss[t] * (1.f / 1024.f) + EPS); const v2u xr = *(const v2u*)(XBI + (size_t)t * D + c); hv = (f32x4){bflo(xr.x), bfhi(xr.x), bflo(xr.y), bfhi(xr.y)} * rs + sh; }
        ring[(r + 16) % W] = hv;
        if (r >= 0) {
            f32x4 S = ring[0];
#pragma unroll
            for (int q = 1; q < W; ++q) S += ring[q];
            const float inv = (tpos0 == 0 && (r + 1) < W) ? (1.f / (float)(r + 1)) : (1.f / (float)W);
            const f32x4 p = S * inv - hv;
            v2u o; o.x = pk2(p[0], p[1]); o.y = pk2(p[2], p[3]);
            *(LAS v2u*)(P + (16 * wave + r) * PS + 4 * lane) = o;
        }
        if (((r + 16) & 7) == 7) asm volatile("" ::: "memory");
    }
}
__device__ __forceinline__ void pool_phase(const bf16* XBI, bf16* XBO, const float* rowss4, float* rowss5, const float* rgk4, const float* shift4, const float* gate4, const float* gk5,
                                           const bf16* WGT, LAS unsigned char* lds, int pm, int gi, int wave_in, int lane_in) {
    LAS bf16* P = (LAS bf16*)lds;
#pragma clang loop unroll(disable)
    for (int q = 0; q < 2; ++q) {
        int lane = lane_in; asm volatile("" : "+v"(lane));
        int wave = wave_in; asm volatile("" : "+s"(wave));
        const int fr = lane & 15, fq = lane >> 4;
        const int tile = 2 * pm + (gi >> 1), g = 2 * (gi & 1) + q, tile0 = tile * 128, b = tile0 >> 11;
        const float* shp = shift4 + (size_t)b * MODW;
        if (g == 0) pool_build<2>(XBI, rowss4, shp, P, tile0, g, wave, lane);
        else if (g == 1) pool_build<4>(XBI, rowss4, shp, P, tile0, g, wave, lane);
        else if (g == 2) pool_build<8>(XBI, rowss4, shp, P, tile0, g, wave, lane);
        else pool_build<16>(XBI, rowss4, shp, P, tile0, g, wave, lane);
        __syncthreads();
        f32x4 acc[8][2];
#pragma unroll
        for (int tb = 0; tb < 8; ++tb) { acc[tb][0] = (f32x4){0.f, 0.f, 0.f, 0.f}; acc[tb][1] = (f32x4){0.f, 0.f, 0.f, 0.f}; }
        const int colb = 256 * g + 32 * wave + 4 * fq;
        v2u xr[8][2];
#pragma unroll
        for (int tb = 0; tb < 8; ++tb)
#pragma unroll
            for (int nb = 0; nb < 2; ++nb) xr[tb][nb] = *(const v2u*)(XBI + (size_t)(tile0 + 16 * tb + fr) * D + colb + 16 * nb);
        const bf16* wbase = WGT + (size_t)(g * 256 + 32 * wave + fr) * 256 + 8 * fq;
#pragma unroll
        for (int kk = 0; kk < 8; ++kk) {
            const bf16x8 wf0 = *(const bf16x8*)(wbase + 32 * kk), wf1 = *(const bf16x8*)(wbase + 16 * 256 + 32 * kk);
#pragma unroll
            for (int tb = 0; tb < 8; ++tb) {
                const bf16x8 pf = *(const LAS bf16x8*)(P + (16 * tb + fr) * PS + 32 * kk + 8 * fq);
                acc[tb][0] = mfma16(wf0, pf, acc[tb][0]); acc[tb][1] = mfma16(wf1, pf, acc[tb][1]);
            }
        }
        f32x4 gt[2], gk[2], rg[2];
#pragma unroll
        for (int nb = 0; nb < 2; ++nb) { gt[nb] = *(const f32x4*)(gate4 + b * 1024 + colb + 16 * nb); gk[nb] = *(const f32x4*)(gk5 + b * 1024 + colb + 16 * nb); rg[nb] = *(const f32x4*)(rgk4 + b * 1024 + colb + 16 * nb); }
        asm volatile("" ::: "memory");
#pragma unroll
        for (int tb = 0; tb < 8; ++tb) {
            const int t = tile0 + 16 * tb + fr; float ss = 0.f;
#pragma unroll
            for (int nb = 0; nb < 2; ++nb) {
                const size_t off = (size_t)t * D + colb + 16 * nb;
                f32x4 xv = (f32x4){bflo(xr[tb][nb].x), bfhi(xr[tb][nb].x), bflo(xr[tb][nb].y), bfhi(xr[tb][nb].y)} * rg[nb]; xv += gt[nb] * acc[tb][nb];
                ss += (xv[0] * xv[0] + xv[1] * xv[1]) + (xv[2] * xv[2] + xv[3] * xv[3]);
                const f32x4 y = xv * gk[nb]; v2u o; o.x = pg8::cvt_pk_bf16(y[0], y[1]); o.y = pg8::cvt_pk_bf16(y[2], y[3]);
                st8_wt(XBO + off, o);
            }
            ss += __shfl_xor(ss, 16); ss += __shfl_xor(ss, 32);
            if (fq == 0) (void)__hip_atomic_fetch_add(rowss5 + t, ss, __ATOMIC_RELAXED, __HIP_MEMORY_SCOPE_AGENT);
        }
        __syncthreads();
    }
}

#define GB_SPIN_CAP (1u << 22)
__device__ __forceinline__ void group_wait_t0(unsigned* cnt, unsigned want) {
    unsigned sp = 0u;
    while (__hip_atomic_load(cnt, __ATOMIC_RELAXED, __HIP_MEMORY_SCOPE_AGENT) < want) { __builtin_amdgcn_s_sleep(1); if (++sp > GB_SPIN_CAP) break; }
    __builtin_amdgcn_fence(__ATOMIC_ACQUIRE, "agent");
    asm volatile("s_waitcnt vmcnt(0)" ::: "memory");
}
__device__ __forceinline__ void group_barrier(unsigned* cnt, unsigned& k, int same_xcc) {
    asm volatile("s_waitcnt vmcnt(0)" ::: "memory");
    __syncthreads();
    if (threadIdx.x == 0) {
        if (!same_xcc) { __builtin_amdgcn_fence(__ATOMIC_RELEASE, "agent");
        asm volatile("s_waitcnt vmcnt(0)" ::: "memory"); }
        (void)__hip_atomic_fetch_add(cnt, 1u, __ATOMIC_RELAXED, __HIP_MEMORY_SCOPE_AGENT);
        asm volatile("buffer_inv sc1" ::: "memory");
        const unsigned want = 4u * (k + 1u); unsigned sp = 0u;
        while (__hip_atomic_load(cnt, __ATOMIC_RELAXED, __HIP_MEMORY_SCOPE_AGENT) < want) { __builtin_amdgcn_s_sleep(1); if (++sp > GB_SPIN_CAP) break; }
        asm volatile("s_waitcnt vmcnt(0)" ::: "memory");
    }
    ++k;
    __syncthreads();
}
__device__ __forceinline__ void neighbour_wait(unsigned* cnt, unsigned want) {
    if (threadIdx.x == 0) group_wait_t0(cnt, want);
    __syncthreads();
}

__device__ __forceinline__ int lane_now() { int z = 0; asm volatile("" : "+v"(z)); return (int)__builtin_amdgcn_mbcnt_hi(~0u, __builtin_amdgcn_mbcnt_lo(~0u, (unsigned)z)); }
struct Args { const float* in[16]; float* out; unsigned char* ws; int never; int pad; };
typedef const __attribute__((address_space(4))) Args* KArgs;
__device__ __forceinline__ KArgs kargs() { KArgs p = (KArgs)__builtin_amdgcn_kernarg_segment_ptr(); asm volatile("" : "+s"(p)); return p; }

__global__ void __launch_bounds__(512, 2) fwd_mega(Args a) {
    extern __shared__ __attribute__((aligned(16))) unsigned char lds_raw[];
    LAS unsigned char* lds = (LAS unsigned char*)lds_raw;
    const int wave = __builtin_amdgcn_readfirstlane((int)threadIdx.x >> 6);
#define lane (lane_now())
#define tid (wave * 64 + lane_now())
    const int G = gridDim.x, bx = blockIdx.x;
    const int gw = bx * 8 + wave, NGW = G * 8;
    for (int u = tid; u < (LDS_BYTES - LDSCTL_OFF) / 4; u += 512) ((LAS unsigned*)(lds + LDSCTL_OFF))[u] = 0u;
    __syncthreads();
    XcdBarrier bar = xcd_barrier_post((unsigned*)(kargs()->ws + WS_CTL) + CW_BAR, (volatile LAS unsigned*)(lds + MISC_OFF) + 8);
    if (kargs()->never) cg::this_grid().sync();
#define GRID_BAR() xcd_barrier(bar)
    const int pm_g = 8 * (bx & 7) + ((bx >> 3) & 7), gi = bx >> 6;
    unsigned gk_n = 0u;
#define GCNT(p) ((unsigned*)(kargs()->ws + WS_CTL) + CW_GRP + 64 * (p))
#ifndef PROBE_BAR2
#define PROBE_BAR2 0
#endif
#define GROUP_BAR() do { group_barrier(GCNT(pm_g), gk_n, same_xcc); if (PROBE_BAR2) group_barrier(GCNT(pm_g), gk_n, same_xcc); } while (0)
#define HALOP ((bf16*)WSP(WS_HALOP))
#define VSTAT ((float*)WSP(WS_VSTAT))
#define IN_(i) (kargs()->in[i])
#define WSP(off) (kargs()->ws + (off))
#define x_in IN_(0)
#define c_in IN_(1)
#define norm_g IN_(2)
#define w_mod IN_(3)
#define b_mod IN_(4)
#define w_ffn_in IN_(5)
#define w_ffn_out IN_(6)
#define ab_w_in IN_(7)
#define ab_norm_v IN_(8)
#define ab_w_s IN_(9)
#define ab_b_s IN_(10)
#define ab_conv_w IN_(11)
#define ab_w_out IN_(12)
#define pool_w_grp IN_(13)
#define pool_scale IN_(14)
#define final_g IN_(15)
#define out (kargs()->out)
#define MOD ((float*)WSP(WS_MOD))
#define GK ((float*)WSP(WS_GK))
#define GATE ((float*)WSP(WS_GATE))
#define BIAS ((float*)WSP(WS_BIAS))
#define ROWSS ((float*)WSP(WS_ROWSS))
#define WST ((bf16*)WSP(WS_WS))
#define WGT ((bf16*)WSP(WS_WGT))
#define WIN ((bf16*)WSP(WS_WIN))
#define WOUT ((bf16*)WSP(WS_WOUT))
#define ABIN ((bf16*)WSP(WS_ABIN))
#define ABOUT ((bf16*)WSP(WS_ABOUT))
#define XB ((bf16*)WSP(WS_XB))
#define YMIX ((bf16*)WSP(WS_YMIX))
#define ACT ((bf16*)WSP(WS_ACT))
#define XB2 ((bf16*)WSP(WS_X2))
#define RGK ((float*)WSP(WS_RGK))

    if (threadIdx.x == 0) __hip_atomic_store((unsigned*)(kargs()->ws + WS_CTL) + CW_XCC + bx, 1u + xb_xcc_id(), __ATOMIC_RELAXED, __HIP_MEMORY_SCOPE_AGENT);
    {
#ifndef PROBE_MOD2
#define PROBE_MOD2 0
#endif
#pragma clang loop unroll(disable)
        for (int rep = 0; rep < 1 + PROBE_MOD2; ++rep)
        if (bx < 144) mod_task(c_in, w_mod, b_mod, MOD, (LAS float*)lds, bx, tid, wave, lane);
        LAS float* scr = (LAS float*)(lds + wave * 16384);
        constexpr int I_IN = 16 * 176, I_OUT = 44 * 32, I_ABIN = 16 * 80, I_ABOUT = 16 * 32, I_PG = 4 * 8;
        constexpr int NITEMS = 4 * I_IN + 4 * I_OUT + I_ABIN + I_ABOUT + 4 * I_PG;
#ifndef PROBE_P0A2
#define PROBE_P0A2 0
#endif
        constexpr int NX = (NITEMS * 764) / 1000;
#pragma clang loop unroll(disable)
        for (int rep = 0; rep < 2 * (1 + PROBE_P0A2); ++rep) {
        const bool second = (rep & 1) != 0;
        if (second && bx < 144) continue;
        const int it0 = second ? NX + (gw - 144 * 8) : gw, its = second ? 112 * 8 : NGW, ite = second ? NITEMS : NX;
        for (int it = it0; it < ite; it += its) {
            int r = it;
            if (r < 4 * I_IN) { const int q = r / I_IN; r -= q * I_IN; transpose_item(w_ffn_in + (size_t)q * D * NIN, D, NIN, WIN + (size_t)q * NIN * D, 1, scr, r, lane); continue; } r -= 4 * I_IN;
            if (r < 4 * I_OUT) { const int q = r / I_OUT; r -= q * I_OUT; transpose_item(w_ffn_out + (size_t)q * FF * D, FF, D, WOUT + (size_t)q * D * FF, 0, scr, r, lane); continue; } r -= 4 * I_OUT;
            if (r < I_ABIN) { transpose_item(ab_w_in, D, NAB, ABIN, 0, scr, r, lane); continue; } r -= I_ABIN;
            if (r < I_ABOUT) { transpose_item(ab_w_out, D, D, ABOUT, 0, scr, r, lane); continue; } r -= I_ABOUT;
            { const int q = r / I_PG; r -= q * I_PG; transpose_item(pool_w_grp + (size_t)q * 65536, 256, 256, WGT + (size_t)q * 65536, 0, scr, r, lane); }
        }
        }
        for (int i = bx * 512 + tid; i < 4 * 128 * 128; i += G * 512) { const int s = i & 127, t = (i >> 7) & 127; WST[i] = (s <= t) ? (bf16)f2bf(ab_w_s[i]) : (bf16)0; }
        for (int i = bx * 512 + tid; i < 6 * T; i += G * 512) ROWSS[T + i] = 0.f;
        for (int i = bx * 512 + tid; i < 2 * T; i += G * 512) VSTAT[i] = 0.f;
    }
    GRID_BAR();
    if (threadIdx.x == 0) {
        const unsigned mine = 1u + xb_xcc_id(), ref = __hip_atomic_load((unsigned*)(kargs()->ws + WS_CTL) + CW_XCC + (bx & 7), __ATOMIC_RELAXED, __HIP_MEMORY_SCOPE_AGENT);
        if (ref != mine) (void)__hip_atomic_fetch_add((unsigned*)(kargs()->ws + WS_CTL) + CW_BAD, 1u, __ATOMIC_RELAXED, __HIP_MEMORY_SCOPE_AGENT);
    }
#ifndef PROBE_P0B2
#define PROBE_P0B2 0
#endif
#pragma clang loop unroll(disable)
    for (int rep = 0; rep < 1 + PROBE_P0B2; ++rep)
    {
        for (int idx = bx * 512 + tid; idx < 6 * 8 * 1024; idx += G * 512) {
            const int i = idx >> 13, b = (idx >> 10) & 7, k = idx & 1023, l = i / 3, s = i - 3 * l;
            const float* mb = MOD + (size_t)(l * 8 + b) * MODW + s * 3072;
            const float gkv = norm_g[i * 1024 + k] * (1.f + mb[1024 + k]);
            GK[idx] = gkv; RGK[idx] = 1.f / gkv;
            float g = mb[2048 + k] * (s == 1 ? 1.f : 0.5f); if (i == 4) g *= pool_scale[k];
            GATE[idx] = g;
        }
        constexpr int BT_IN = NIN / 16, BT_AB = NAB / 16, NBT = 4 * BT_IN + BT_AB;
        const int fr = lane & 15, fq = lane >> 4;
        for (int tk = gw; tk < NBT; tk += NGW) {
            int g, r0, N, i; const bf16* Bt;
            if (tk < 4 * BT_IN) { g = tk / BT_IN; r0 = (tk - g * BT_IN) * 16; Bt = WIN + (size_t)g * NIN * D; N = NIN; i = (g >> 1) * 3 + (g & 1) * 2; }
            else { g = 4; r0 = (tk - 4 * BT_IN) * 16; Bt = ABIN; N = NAB; i = 1; }
            const int l = i / 3, s = i - 3 * l;
            const float* shp = MOD + (size_t)(l * 8 + (fr & 7)) * MODW + s * 3072 + 8 * fq;
            const bf16* ap = Bt + (size_t)(r0 + fr) * D + 8 * fq;
            f32x4 acc = (f32x4){0.f, 0.f, 0.f, 0.f};
#pragma unroll 4
            for (int kk = 0; kk < 32; ++kk) {
                const bf16x8 av = *(const bf16x8*)(ap + 32 * kk);
                const f32x4 s0 = *(const f32x4*)(shp + 32 * kk), s1 = *(const f32x4*)(shp + 32 * kk + 4);
                float hi[8], lo[8];
#pragma unroll
                for (int j = 0; j < 4; ++j) { hi[j] = __uint_as_float(f2bf(s0[j]) << 16); lo[j] = s0[j] - hi[j]; hi[4 + j] = __uint_as_float(f2bf(s1[j]) << 16); lo[4 + j] = s1[j] - hi[4 + j]; }
                acc = mfma16(av, pack8(hi), acc); acc = mfma16(av, pack8(lo), acc);
            }
            if (fr < 8) *(f32x4*)(BIAS + (size_t)g * BIAS_STRIDE_F + (size_t)fr * N + r0 + 4 * fq) = acc;
        }
        for (int m0 = gw * 4; m0 < T; m0 += NGW * 4) {
            const int b = m0 >> 11; const float* mb = MOD + (size_t)b * MODW + 1024;
            f32x4 v[4][4]; f32x4 gkv[4];
#pragma unroll
            for (int r = 0; r < 4; ++r)
#pragma unroll
                for (int j = 0; j < 4; ++j) v[r][j] = *(const f32x4*)(x_in + (size_t)(m0 + r) * D + 4 * lane + 256 * j);
#pragma unroll
            for (int j = 0; j < 4; ++j) { const int c = 4 * lane + 256 * j; gkv[j] = *(const f32x4*)(norm_g + c) * (*(const f32x4*)(mb + c) + 1.f); }
            asm volatile("" ::: "memory");
#pragma unroll
            for (int r = 0; r < 4; ++r) {
                float ss = 0.f;
#pragma unroll
                for (int j = 0; j < 4; ++j) ss += (v[r][j][0] * v[r][j][0] + v[r][j][1] * v[r][j][1]) + (v[r][j][2] * v[r][j][2] + v[r][j][3] * v[r][j][3]);
                ss = wave_sum(ss); if (lane == 0) ROWSS[m0 + r] = ss;
#pragma unroll
                for (int j = 0; j < 4; ++j) { const f32x4 y = v[r][j] * gkv[j]; v2u o; o.x = pk2(y[0], y[1]); o.y = pk2(y[2], y[3]); *(v2u*)(XB + (size_t)(m0 + r) * D + 4 * lane + 256 * j) = o; }
            }
        }
    }
    GRID_BAR();
    int same_xcc;
    {
        volatile LAS unsigned* fl = (volatile LAS unsigned*)(lds + MISC_OFF) + 12;
        if (threadIdx.x == 0) fl[0] = (__hip_atomic_load((unsigned*)(kargs()->ws + WS_CTL) + CW_BAD, __ATOMIC_RELAXED, __HIP_MEMORY_SCOPE_AGENT) == 0u && G == 256) ? 1u : 0u;
        __syncthreads();
        same_xcc = __builtin_amdgcn_readfirstlane((int)fl[0]);
    }
#ifndef STAG_TICKS
#define STAG_TICKS 0
#endif
    if (STAG_TICKS > 0) {
        const unsigned long long t0 = __builtin_amdgcn_s_memrealtime(); const unsigned long long d = (unsigned long long)STAG_TICKS * (unsigned)(pm_g & 7);
        while (__builtin_amdgcn_s_memrealtime() - t0 < d) __builtin_amdgcn_s_sleep(16);
    }
#pragma clang loop unroll(disable)
    for (int f = 0; f < 4; ++f) {
        const int l = f >> 1, i = 3 * l + 2 * (f & 1);
#ifndef PROBE_FIN2
#define PROBE_FIN2 0
#endif
#pragma clang loop unroll(disable)
        for (int rep = 0; rep < 1 + PROBE_FIN2; ++rep)
        {
            pg8::Gemm g{f == 3 ? XB2 : XB, WIN + (size_t)f * NIN * D, T, NIN, D}; pg8::StaticOrder S; S.init(T, 20 * 256, G, bx);
            EpiSwiglu E{ACT, ROWSS + (size_t)i * T, BIAS + (size_t)f * BIAS_STRIDE_F};
            pg8::gemm_phase<EpiSwiglu, pg8::StaticOrder, true, true>(lds, g, S, E, wave);
            const pg8::Unit hu{pm_g, 20 + (gi & 1), gi >> 1, 1};
            pg8::gemm_half<EpiSwiglu>(lds, g.A, g.Bt, D, hu, E, wave);
        }
        GROUP_BAR();
#ifndef PROBE_FOUTK
#define PROBE_FOUTK 0
#endif
        if (f < 3) {
            pg8::Gemm g{ACT, WOUT + (size_t)f * D * FF, T, D, FF}; pg8::StaticOrder S; S.init(T, D, G, bx);
            EpiResid E{XB, RGK + (size_t)i * 8192, GATE + (size_t)i * 8192, ROWSS + (size_t)(i + 1) * T, GK + (size_t)(i + 1) * 8192, XB, out};
            pg8::gemm_phase<EpiResid, pg8::StaticOrder, true, true>(lds, g, S, E, wave);
        } else {
            pg8::Gemm g{ACT, WOUT + (size_t)f * D * FF, T, D, FF}; pg8::StaticOrder S; S.init(T, D, G, bx);
            EpiResidFinal E{XB2, RGK + (size_t)i * 8192, GATE + (size_t)i * 8192, ROWSS + (size_t)(i + 1) * T, final_g, out, GCNT(pm_g), gk_n, same_xcc};
            pg8::gemm_phase<EpiResidFinal, pg8::StaticOrder, true, true>(lds, g, S, E, wave);
            break;
        }
        GROUP_BAR();
        if (f == 0) {
#ifndef PROBE_MIN2
#define PROBE_MIN2 0
#endif
#pragma clang loop unroll(disable)
            for (int rep = 0; rep < 1 + PROBE_MIN2; ++rep)
            {
                pg8::Gemm g{XB, ABIN, T, NAB, D}; pg8::StaticOrder S; S.init(T, 8 * 256, G, bx);
                EpiProj E{ACT, ROWSS + (size_t)1 * T, BIAS + (size_t)4 * BIAS_STRIDE_F, HALOP, VSTAT};
                pg8::gemm_phase<EpiProj, pg8::StaticOrder, true, true>(lds, g, S, E, wave);
                const pg8::Unit hu{pm_g, 8 + (gi & 1), gi >> 1, 1};
                pg8::gemm_half<EpiProj>(lds, g.A, g.Bt, D, hu, E, wave);
            }
            GROUP_BAR();
            if ((pm_g & 7) != 0 && gi == 0) neighbour_wait(GCNT(pm_g - 1), 4u * gk_n);
#ifndef PROBE_MID2
#define PROBE_MID2 0
#endif
#pragma clang loop unroll(disable)
            for (int rep = 0; rep < 1 + PROBE_MID2; ++rep)
            mid_phase(ACT, YMIX, WST, ab_norm_v, ab_b_s, ab_conv_w, HALOP, VSTAT, lds, pm_g, gi, wave, lane);
            GROUP_BAR();
            {
                pg8::Gemm g{YMIX, ABOUT, T, D, D}; pg8::StaticOrder S; S.init(T, D, G, bx);
                EpiResid E{XB, RGK + (size_t)1 * 8192, GATE + (size_t)1 * 8192, ROWSS + (size_t)2 * T, GK + (size_t)2 * 8192, XB, out};
                pg8::gemm_phase<EpiResid, pg8::StaticOrder, true, true>(lds, g, S, E, wave);
            }
            GROUP_BAR();
        } else if (f == 2) {
            if ((pm_g & 7) != 0 && gi < 2) neighbour_wait(GCNT(pm_g - 1), 4u * gk_n);
            pool_phase(XB, XB2, ROWSS + (size_t)4 * T, ROWSS + (size_t)5 * T, RGK + (size_t)4 * 8192, MOD + (size_t)8 * MODW + 3072, GATE + (size_t)4 * 8192, GK + (size_t)5 * 8192,
                       WGT, lds, pm_g, gi, wave, lane);
            GROUP_BAR();
        }
    }
}

#undef tid
#undef lane
#undef GRID_BAR
#undef GROUP_BAR
#undef GCNT
#undef HALOP
#undef VSTAT
#undef IN_
#undef WSP
#undef x_in
#undef c_in
#undef norm_g
#undef w_mod
#undef b_mod
#undef w_ffn_in
#undef w_ffn_out
#undef ab_w_in
#undef ab_norm_v
#undef ab_w_s
#undef ab_b_s
#undef ab_conv_w
#undef ab_w_out
#undef pool_w_grp
#undef pool_scale
#undef final_g
#undef out
#undef MOD
#undef GK
#undef GATE
#undef BIAS
#undef ROWSS
#undef WST
#undef WGT
#undef WIN
#undef WOUT
#undef ABIN
#undef ABOUT
#undef XB
#undef YMIX
#undef ACT
#undef XB2
#undef RGK

extern "C" void kernel_launch(void* const* d_in, const int* in_sizes, int n_in, void* d_out, int out_size, void* d_ws, size_t ws_size, hipStream_t stream) {
    static int grid = 0;
    if (grid == 0) {
        if (n_in != 16 || in_sizes[0] != T * D || out_size != T * D || ws_size < WS_END) { fprintf(stderr, "kernel_launch: unexpected shapes (n_in %d, in0 %d, out %d, ws %zu)\n", n_in, n_in > 0 ? in_sizes[0] : -1, out_size, ws_size); grid = -1; return; }
        int dev = 0, cus = 0, per_cu = 0;
        if (hipGetDevice(&dev) != hipSuccess || hipDeviceGetAttribute(&cus, hipDeviceAttributeMultiprocessorCount, dev) != hipSuccess) { grid = -1; return; }
        if (hipFuncSetAttribute((const void*)fwd_mega, hipFuncAttributeMaxDynamicSharedMemorySize, LDS_BYTES) != hipSuccess) { fprintf(stderr, "kernel_launch: hipFuncSetAttribute failed\n"); grid = -1; return; }
        if (hipOccupancyMaxActiveBlocksPerMultiprocessor(&per_cu, (const void*)fwd_mega, 512, LDS_BYTES) != hipSuccess || per_cu < 1) { fprintf(stderr, "kernel_launch: occupancy query says %d blocks per CU\n", per_cu); per_cu = 1; }
        (void)hipGetLastError();
        if (cus < 256) { fprintf(stderr, "kernel_launch: built for a 256-CU device (got %d CUs)\n", cus); grid = -1; return; }
        grid = 256;
    }
    if (grid < 0) return;
    (void)hipMemsetAsync((char*)d_ws + WS_CTL, 0, CTL_ZERO_BYTES, stream);
    Args a{};
    for (int i = 0; i < 16; ++i) a.in[i] = (const float*)d_in[i];
    a.out = (float*)d_out; a.ws = (unsigned char*)d_ws; a.never = 0; a.pad = 0;
    void* args[] = {&a};
    const hipError_t e = hipLaunchCooperativeKernel((const void*)fwd_mega, dim3(grid), dim3(512), args, LDS_BYTES, stream);
    if (e != hipSuccess) fprintf(stderr, "kernel_launch: cooperative launch failed: %s (grid %d)\n", hipGetErrorString(e), grid);
}
```
